# Optimizing an MI355X kernel written in HIP

```python
import jax
import jax.numpy as jnp
from jax import lax
import numpy as np

D_MODEL = 1024
BATCH = 32
SEQ = 256
DEPTH = 1
DEC_BATCH = 4
DEC_SEQ = 4096
PAST_LEN = 512

GRID_W = 64
MLA_HEADS = 8
Q_LORA = 384
KV_LORA = 256
QK_NOPE = 64
QK_ROPE = 32
V_HEAD = 64
MLA_W = MLA_HEADS * V_HEAD
MLA_SCALE = (QK_NOPE + QK_ROPE) ** -0.5
HG_HEADS = 8
HG_DK = 64
HG_DV = 64
HG_KW = HG_HEADS * HG_DK
HG_W = HG_HEADS * HG_DV
HG_CHUNK = 32
N_DIR = 2
D_FF = 4 * D_MODEL
Q_BLOCK = 128
ROPE_BASE = 10000.0
EPS = 1e-6
IN_SIZES = (Q_LORA, KV_LORA, QK_ROPE, HG_KW, HG_KW, HG_KW, HG_W, HG_W, D_MODEL, D_MODEL)
IN_OFFSETS = tuple(int(o) for o in np.cumsum(IN_SIZES)[:-1])
N_IN = sum(IN_SIZES)

kernel_name = "hybrid_mla_hgrn2_prefix_dit_step"


def rms_norm(x, g):
    xf = x.astype(jnp.float32)
    y = xf * lax.rsqrt(jnp.mean(xf * xf, axis=-1, keepdims=True) + EPS)
    return (y * g.astype(jnp.float32)).astype(x.dtype)


def axial_rope(n):
    rows = n // GRID_W
    row = jnp.repeat(jnp.arange(rows, dtype=jnp.float32), GRID_W)
    col = jnp.tile(jnp.arange(GRID_W, dtype=jnp.float32), rows)
    half = QK_ROPE // 2
    inv = ROPE_BASE ** (-jnp.arange(0, half, 2, dtype=jnp.float32) / half)
    ang = jnp.concatenate([row[:, None] * inv, col[:, None] * inv], axis=-1)
    return jnp.cos(ang), jnp.sin(ang)


def apply_rope(x, cos, sin):
    x1 = x[..., 0::2].astype(jnp.float32)
    x2 = x[..., 1::2].astype(jnp.float32)
    out = jnp.stack([x1 * cos - x2 * sin, x1 * sin + x2 * cos], axis=-1)
    return out.reshape(x.shape).astype(x.dtype)


def mla_attend(q_nope, q_rope, k_nope, k_rope, v):
    b, nq, h, _ = q_nope.shape
    nb = nq // Q_BLOCK

    def blocks(a):
        return a.reshape(b, nb, Q_BLOCK, h, a.shape[-1]).swapaxes(0, 1)

    def attend_block(qs):
        qn, qr = qs
        s = jnp.einsum('bqhd,bkhd->bhqk', qn, k_nope) + jnp.einsum('bqhr,bkr->bhqk', qr, k_rope)
        p = jax.nn.softmax(s.astype(jnp.float32) * MLA_SCALE, axis=-1).astype(v.dtype)
        return jnp.einsum('bhqk,bkhd->bqhd', p, v)

    o = lax.map(attend_block, (blocks(q_nope), blocks(q_rope)))
    return o.swapaxes(0, 1).reshape(b, nq, h * V_HEAD)


def hgrn2_chunk_scan(q, k, v, log_f, s0):
    b, n, h, _ = q.shape
    dv = v.shape[-1]
    nc = n // HG_CHUNK

    def chunks(a):
        return a.reshape(b, nc, HG_CHUNK, h, a.shape[-1]).transpose(1, 0, 3, 2, 4)

    tri = jnp.tril(jnp.ones((HG_CHUNK, HG_CHUNK), dtype=bool))[:, :, None]

    def step(s, inp):
        qc, kc, vc, gc = inp
        cum = jnp.cumsum(gc, axis=2)
        diff = cum[:, :, :, None, :] - cum[:, :, None, :, :]
        decay = jnp.exp(jnp.where(tri, diff, -jnp.inf))
        scores = jnp.einsum('bhtk,bhsk,bhtsk->bhts', qc, kc, decay)
        o = jnp.einsum('bhts,bhsv->bhtv', scores, vc) + jnp.einsum('bhtk,bhkv->bhtv', qc * jnp.exp(cum), s)
        last = cum[:, :, -1, :]
        s_new = jnp.exp(last)[..., None] * s + jnp.einsum(
            'bhsk,bhsv->bhkv', kc * jnp.exp(last[:, :, None, :] - cum), vc)
        return s_new, o

    s_fin, o = lax.scan(step, s0, (chunks(q), chunks(k), chunks(v), chunks(log_f)))
    return o.transpose(1, 0, 3, 2, 4).reshape(b, n, h, dv), s_fin


def token_mixers(h, lw, rope, ctx):
    (w_in, g_q, w_uq, g_kv, w_ukv, g_hg, lb, w_br_mla, w_br_hg, w_out) = lw
    b, n, _ = h.shape
    f32 = jnp.float32
    (q_lat, kv_lat, k_rope, hq, hf_fwd, hf_bwd, hi, hg, gate_mla, gate_hg) = jnp.split(
        h @ w_in, IN_OFFSETS, axis=-1)

    q = (rms_norm(q_lat, g_q) @ w_uq).reshape(b, n, MLA_HEADS, QK_NOPE + QK_ROPE)
    q_nope, q_rope = q[..., :QK_NOPE], q[..., QK_NOPE:]
    ckv = rms_norm(kv_lat, g_kv)
    kv = (ckv @ w_ukv).reshape(b, n, MLA_HEADS, QK_NOPE + V_HEAD)
    k_nope, v = kv[..., :QK_NOPE], kv[..., QK_NOPE:]
    if ctx is None:
        o_mla = mla_attend(q_nope, q_rope, k_nope, k_rope, v)
        s0_f = jnp.zeros((b, HG_HEADS, HG_DK, HG_DV), f32)
        s0_b = jnp.zeros((b, HG_HEADS, HG_DK, HG_DV), f32)
    else:
        ckv_c, krope_c, state_c = ctx
        cos, sin = rope
        q_rope = apply_rope(q_rope, cos[:, None, :], sin[:, None, :])
        k_rope_lat = apply_rope(k_rope, cos, sin)
        kv_c = (ckv_c @ w_ukv).reshape(b, ckv_c.shape[1], MLA_HEADS, QK_NOPE + V_HEAD)
        o_mla = mla_attend(
            q_nope, q_rope,
            jnp.concatenate([k_nope, kv_c[..., :QK_NOPE]], axis=1),
            jnp.concatenate([k_rope_lat, krope_c], axis=1),
            jnp.concatenate([v, kv_c[..., QK_NOPE:]], axis=1))
        s0_f = state_c[:, 0].astype(f32)
        s0_b = state_c[:, 1].astype(f32)

    qh = (jax.nn.silu(hq.astype(f32)) * HG_DK ** -0.5).reshape(b, n, HG_HEADS, HG_DK)
    vh = hi.astype(f32).reshape(b, n, HG_HEADS, HG_DV)

    def forget(z, lbd):
        f = lbd + (1.0 - lbd) * jax.nn.sigmoid(z.astype(f32))
        return ((1.0 - f).reshape(b, n, HG_HEADS, HG_DK),
                jnp.log(f).reshape(b, n, HG_HEADS, HG_DK))

    k_f, lf_f = forget(hf_fwd, lb[0])
    k_b, lf_b = forget(hf_bwd, lb[1])
    o_f, s_f = hgrn2_chunk_scan(qh, k_f, vh, lf_f, s0_f)
    rev = lambda a: jnp.flip(a, axis=1)
    o_b, s_b = hgrn2_chunk_scan(rev(qh), rev(k_b), rev(vh), rev(lf_b), s0_b)
    o_hg = rms_norm(o_f + rev(o_b), g_hg.reshape(HG_HEADS, HG_DV)).reshape(b, n, HG_W)
    o_hg = o_hg.astype(h.dtype) * jax.nn.silu(hg)

    merged = jax.nn.sigmoid(gate_mla) * (o_mla @ w_br_mla) + jax.nn.sigmoid(gate_hg) * (o_hg @ w_br_hg)
    out = merged @ w_out
    if ctx is None:
        return out, (ckv, k_rope, jnp.stack([s_f, s_b], axis=1))
    return out, None


def trunk_layer(x, mods, g_mix, g_ff, lw, w_ff1, w_ff2, rope, ctx):
    sh1, sc1, ga1, sh2, sc2, ga2 = [m[:, None, :] for m in mods]
    h = rms_norm(x, g_mix) * (1.0 + sc1) + sh1
    mix, state = token_mixers(h, lw, rope, ctx)
    x = x + ga1 * mix
    h = rms_norm(x, g_ff) * (1.0 + sc2) + sh2
    x = x + ga2 * (jnp.square(jax.nn.relu(h @ w_ff1)) @ w_ff2)
    return x, state


def setup_inputs(seed: int = 0) -> dict:
    key = jax.random.key(seed)
    ks = jax.random.split(key, 26)
    f32 = jnp.float32

    def nrm(k, shape, scale):
        return jax.random.normal(k, shape, f32) * scale

    def gain(k, shape):
        return 1.0 + nrm(k, shape, 0.01)

    return {
        "x_prompt": nrm(ks[0], (BATCH, SEQ, D_MODEL), 1.0),
        "x_sample": nrm(ks[1], (DEC_BATCH, DEC_SEQ, D_MODEL), 1.0),
        "cache_ckv": nrm(ks[2], (DEC_BATCH, DEPTH, PAST_LEN, KV_LORA), 1.0),
        "cache_krope": nrm(ks[3], (DEC_BATCH, DEPTH, PAST_LEN, QK_ROPE), 1.0),
        "state_hgrn": nrm(ks[4], (DEC_BATCH, DEPTH, N_DIR, HG_HEADS, HG_DK, HG_DV), 0.3),
        "c": nrm(ks[5], (DEC_BATCH, D_MODEL), 1.0),
        "c_ctx": nrm(ks[6], (D_MODEL,), 1.0),
        "w_ada": nrm(ks[7], (DEPTH, D_MODEL, 6 * D_MODEL), 0.5 * D_MODEL ** -0.5),
        "b_ada": nrm(ks[8], (DEPTH, 6 * D_MODEL), 0.02),
        "g_norm_mix": gain(ks[9], (DEPTH, D_MODEL)),
        "g_norm_ff": gain(ks[10], (DEPTH, D_MODEL)),
        "w_in": nrm(ks[11], (DEPTH, D_MODEL, N_IN), D_MODEL ** -0.5),
        "g_q_norm": gain(ks[12], (DEPTH, Q_LORA)),
        "w_uq": nrm(ks[13], (DEPTH, Q_LORA, MLA_HEADS * (QK_NOPE + QK_ROPE)), Q_LORA ** -0.5),
        "g_kv_norm": gain(ks[14], (DEPTH, KV_LORA)),
        "w_ukv": nrm(ks[15], (DEPTH, KV_LORA, MLA_HEADS * (QK_NOPE + V_HEAD)), KV_LORA ** -0.5),
        "g_hg_norm": gain(ks[16], (DEPTH, HG_W)),
        "hg_lb_logits": nrm(ks[17], (DEPTH + 1, N_DIR, HG_KW), 0.5),
        "w_br_mla": nrm(ks[18], (DEPTH, MLA_W, D_MODEL), MLA_W ** -0.5),
        "w_br_hg": nrm(ks[19], (DEPTH, HG_W, D_MODEL), HG_W ** -0.5),
        "w_out": nrm(ks[20], (DEPTH, D_MODEL, D_MODEL), D_MODEL ** -0.5),
        "w_ff1": nrm(ks[21], (DEPTH, D_MODEL, D_FF), D_MODEL ** -0.5),
        "w_ff2": nrm(ks[22], (DEPTH, D_FF, D_MODEL), D_FF ** -0.5),
        "g_final": gain(ks[23], (D_MODEL,)),
    }


def reference(x_prompt, x_sample, cache_ckv, cache_krope, state_hgrn, c, c_ctx, w_ada, b_ada,
              g_norm_mix, g_norm_ff, w_in, g_q_norm, w_uq, g_kv_norm, w_ukv, g_hg_norm, hg_lb_logits,
              w_br_mla, w_br_hg, w_out, w_ff1, w_ff2, g_final):
    lb_all = jnp.cumsum(jax.nn.softmax(hg_lb_logits.astype(jnp.float32), axis=0), axis=0)
    rope = axial_rope(x_sample.shape[1])
    x_c, x_l = x_prompt, x_sample
    ckv_list, krope_list, st_list = [], [], []
    for l in range(DEPTH):
        lw = (w_in[l], g_q_norm[l], w_uq[l], g_kv_norm[l], w_ukv[l], g_hg_norm[l], lb_all[l],
              w_br_mla[l], w_br_hg[l], w_out[l])
        mods_c = jnp.split(jax.nn.silu(c_ctx[None, :]) @ w_ada[l] + b_ada[l], 6, axis=-1)
        mods_l = jnp.split(jax.nn.silu(c) @ w_ada[l] + b_ada[l], 6, axis=-1)
        x_c, (ckv, krope, st) = trunk_layer(x_c, mods_c, g_norm_mix[l], g_norm_ff[l], lw,
                                            w_ff1[l], w_ff2[l], None, None)
        ckv_list.append(ckv)
        krope_list.append(krope)
        st_list.append(st)
        x_l, _ = trunk_layer(x_l, mods_l, g_norm_mix[l], g_norm_ff[l], lw, w_ff1[l], w_ff2[l], rope,
                             (cache_ckv[:, l], cache_krope[:, l], state_hgrn[:, l]))
    y_prompt = rms_norm(x_c, g_final)
    y_sample = rms_norm(x_l, g_final)
    return (y_prompt, y_sample, jnp.stack(ckv_list, axis=1), jnp.stack(krope_list, axis=1),
            jnp.stack(st_list, axis=1))
```

```cpp
#include <hip/hip_runtime.h>
#include <hip/hip_cooperative_groups.h>
#include <cstdint>
#include <cstdio>
namespace cg = cooperative_groups;

#define LAS __attribute__((address_space(3)))
typedef unsigned short bf16_t;
typedef short bf16x8 __attribute__((ext_vector_type(8)));
typedef float f32x4 __attribute__((ext_vector_type(4)));
typedef float f32x2 __attribute__((ext_vector_type(2)));
typedef float f32x16 __attribute__((ext_vector_type(16)));
typedef unsigned u32x4 __attribute__((ext_vector_type(4)));
typedef unsigned u32x2 __attribute__((ext_vector_type(2)));
typedef __bf16 bf16x2_t __attribute__((ext_vector_type(2)));

constexpr int DM = 1024, TP = 8192, TSM = 16384, T = 24576, KRN = 26624, NKS = 4608, NIN = 5280;
constexpr float EPS = 1e-6f;
constexpr float QSCALE = 0.10206207261596575f * 1.4426950408889634f;
constexpr size_t MiB = 1u << 20;
constexpr size_t WS_RSQ = 0, WS_RSKV = 128 * 1024, WS_MODS = 256 * 1024, WS_LB = 384 * 1024, WS_ROPE = 512 * 1024;
constexpr size_t WS_WIN = 2 * MiB, WS_WG = WS_WIN + (size_t)3328 * 1024 * 2, WS_WUQ = WS_WG + 4 * MiB, WS_WUK = 13 * MiB + 256 * 1024, WS_WUV = 13 * MiB + 512 * 1024;
constexpr size_t WS_W1 = 14 * MiB, WS_W2 = 15 * MiB, WS_WOUT = 16 * MiB, WS_WFF1 = 18 * MiB, WS_WFF2 = 26 * MiB;
constexpr size_t WS_H = 34 * MiB, WS_QLAT = 82 * MiB, WS_CKVA = 100 * MiB, WS_OMLA = 82 * MiB;
constexpr size_t WS_HQ = 113 * MiB, WS_KKF = 137 * MiB, WS_KKB = 161 * MiB, WS_HI = 185 * MiB, WS_HG = 209 * MiB, WS_SL = 233 * MiB, WS_DD = 249 * MiB;
constexpr size_t WS_G = 113 * MiB, WS_MERGED = 34 * MiB, WS_H2 = 82 * MiB, WS_HID = 130 * MiB;
constexpr size_t DO_Q = 0, DO_KN = 36 * MiB, DO_KR = 62 * MiB, DO_VTP = 64 * MiB, DO_VTS = 72 * MiB;
constexpr size_t OUT_CKV = 25165824, OUT_KROPE = 27262976, OUT_STATE = 27525120;
constexpr int LDS_BYTES = 147456;

__device__ __forceinline__ unsigned cvtpk(float lo, float hi) { f32x2 v = {lo, hi}; bf16x2_t b = __builtin_convertvector(v, bf16x2_t); return __builtin_bit_cast(unsigned, b); }
__device__ __forceinline__ float bf2f(unsigned short b) { return __uint_as_float(((unsigned)b) << 16); }
__device__ __forceinline__ float bflo(unsigned w) { return __uint_as_float(w << 16); }
__device__ __forceinline__ float bfhi(unsigned w) { return __uint_as_float(w & 0xffff0000u); }
__device__ __forceinline__ void st8(bf16_t* p, f32x4 a, f32x4 b) { u32x4 w; w.x = cvtpk(a[0], a[1]); w.y = cvtpk(a[2], a[3]); w.z = cvtpk(b[0], b[1]); w.w = cvtpk(b[2], b[3]); *(u32x4*)p = w; }
__device__ __forceinline__ float sigm(float v) { return __builtin_amdgcn_rcpf(1.f + __expf(-v)); }
__device__ __forceinline__ float silu(float v) { return v * sigm(v); }
__device__ __forceinline__ float wave_sum(float v) {
#pragma unroll
    for (int o = 1; o < 64; o <<= 1) v += __shfl_xor(v, o);
    return v;
}

namespace pg8 {
constexpr int BM = 256, BK = 64, HALF = 128, HTB = HALF * BK * 2, STAGE_BYTES = 8 * HTB;
__host__ __device__ __forceinline__ int lds_byte(int r, int c) { const int st = (r >> 4) * 2 + (c >> 5), rr = r & 15, cc = c & 31, ob = rr * 64 + cc * 2; return st * 1024 + (ob ^ (((ob >> 9) & 1) << 5)); }
__host__ __device__ __forceinline__ void stage_rc(int b, int& R, int& C) { const int st = b / 1024, sb = b % 1024, swz = sb ^ (((sb >> 9) & 1) << 5); R = (st >> 1) * 16 + swz / 64; C = (st & 1) * 32 + (swz % 64) / 2; }
__host__ __device__ __forceinline__ int perm32(int rho) { const int n = rho >> 4, i = rho & 15; return 8 * (i >> 2) + 4 * n + (i & 3); }
struct Unit { const char* A; const char* B; int pm, pn, flags; };

template <class Epi, class Sched>
__device__ __forceinline__ void gemm_phase(LAS unsigned char* lds, const int lda, const int ldb, const int K, const Sched& S, const Epi& E) {
    int tid_ = threadIdx.x; asm volatile("" : "+v"(tid_));
    const int tid = tid_, wid = __builtin_amdgcn_readfirstlane(tid >> 6), lane = tid & 63, wr = wid >> 2, wc = wid & 3, fr = lane & 15, fq = lane >> 4;
    const int nt = K / BK;
    unsigned voffA[2], voffB[2];
#pragma unroll
    for (int i = 0; i < 2; ++i) { int R, C; stage_rc(tid * 16 + i * 8192, R, C); const int Rb = Epi::PERM ? ((R & ~31) + perm32(R & 31)) : R;
        voffA[i] = (unsigned)(R * lda + C) * 2u; voffB[i] = (unsigned)(Rb * ldb + C) * 2u; }
    const size_t kstep = (size_t)(BK * 2);
    const size_t hstepA = (size_t)HALF * lda * 2, hstepB = (size_t)HALF * ldb * 2;
    const unsigned ldsw = (unsigned)wid * 1024u;
    const int aoff = lds_byte(wr * 64 + fr, fq * 8), boff = lds_byte(wc * 32 + fr, fq * 8);
#define PG8_SA(b, h) (((b) * 2 + (h)) * HTB)
#define PG8_SB(b, h) ((4 + (b) * 2 + (h)) * HTB)
#define PG8_STAGE(bufoff, gbase, voff) do { _Pragma("unroll") for (int _i = 0; _i < 2; ++_i) \
        __builtin_amdgcn_global_load_lds((const unsigned*)((const char*)(gbase) + (voff)[_i]), (LAS unsigned*)(lds + (bufoff) + ldsw + _i * 8192), 16, 0, 0); } while (0)
#define PG8_LDA(dst, b, h) do { _Pragma("unroll") for (int m = 0; m < 4; ++m) _Pragma("unroll") for (int k = 0; k < 2; ++k) dst[m][k] = *(const LAS bf16x8*)(lds + PG8_SA(b, h) + aoff + m * 2048 + k * 1024); } while (0)
#define PG8_LDB(dst, b, h) do { _Pragma("unroll") for (int n = 0; n < 2; ++n) _Pragma("unroll") for (int k = 0; k < 2; ++k) dst[n][k] = *(const LAS bf16x8*)(lds + PG8_SB(b, h) + boff + n * 2048 + k * 1024); } while (0)
#define PG8_MMA(ai, bj, At, Bt) do { __builtin_amdgcn_s_setprio(1); _Pragma("unroll") for (int m = 0; m < 4; ++m) _Pragma("unroll") for (int n = 0; n < 2; ++n) _Pragma("unroll") for (int k = 0; k < 2; ++k) \
        acc[ai][bj][m][n] = Epi::SWAP ? __builtin_amdgcn_mfma_f32_16x16x32_bf16(At[m][k], Bt[n][k], acc[ai][bj][m][n], 0, 0, 0) \
                                      : __builtin_amdgcn_mfma_f32_16x16x32_bf16(Bt[n][k], At[m][k], acc[ai][bj][m][n], 0, 0, 0); __builtin_amdgcn_s_setprio(0); } while (0)
#define PG8_WAIT_V(n) asm volatile("s_waitcnt vmcnt(" #n ")" ::: "memory")
#define PG8_WAIT_L(n) asm volatile("s_waitcnt lgkmcnt(" #n ")" ::: "memory")
#define PG8_BAR __builtin_amdgcn_s_barrier()
#define PG8_SCHED __builtin_amdgcn_sched_barrier(0)
    Unit cur, nxt; int ui = 0;
    if (!S.next(0, cur)) return;
    f32x4 acc[2][2][4][2];
#pragma unroll
    for (int a = 0; a < 2; ++a)
#pragma unroll
        for (int b = 0; b < 2; ++b)
#pragma unroll
            for (int m = 0; m < 4; ++m)
#pragma unroll
                for (int n = 0; n < 2; ++n) acc[a][b][m][n] = (f32x4){0.f, 0.f, 0.f, 0.f};
    bf16x8 At[4][2], B0[2][2], B1[2][2];
    const char* cA = cur.A; const char* cB = cur.B;
    PG8_STAGE(PG8_SB(0, 0), cB, voffB); PG8_STAGE(PG8_SB(0, 1), cB + hstepB, voffB); PG8_STAGE(PG8_SA(0, 0), cA, voffA); PG8_STAGE(PG8_SA(0, 1), cA + hstepA, voffA);
    if (wr == 1) PG8_BAR;
    PG8_WAIT_V(2); PG8_BAR;
    PG8_STAGE(PG8_SB(1, 0), cB + kstep, voffB); PG8_STAGE(PG8_SA(1, 0), cA + kstep, voffA); PG8_STAGE(PG8_SB(1, 1), cB + hstepB + kstep, voffB);
    PG8_WAIT_V(6); PG8_BAR;
    for (;;) {
        const bool has_next = S.next(ui + 1, nxt);
        const char* nA = has_next ? nxt.A : cA; const char* nB = has_next ? nxt.B : cB;
#pragma unroll 1
        for (int t = 0; t < nt; t += 2) {
            const bool last = (t == nt - 2);
            const char* a1 = cA + (size_t)(t + 1) * kstep;
            const char* a2 = last ? nA : cA + (size_t)(t + 2) * kstep; const char* b2 = last ? nB : cB + (size_t)(t + 2) * kstep;
            const char* a3 = a2 + kstep; const char* b3 = b2 + kstep;
            PG8_LDB(B0, 0, 0); PG8_LDB(B1, 0, 1); PG8_SCHED; PG8_LDA(At, 0, 0); PG8_STAGE(PG8_SA(1, 1), a1 + hstepA, voffA);
            PG8_WAIT_V(8); PG8_WAIT_L(0); PG8_BAR; PG8_MMA(0, 0, At, B0); PG8_MMA(0, 1, At, B1); PG8_BAR; PG8_SCHED;
            PG8_LDA(At, 0, 1); PG8_STAGE(PG8_SB(0, 0), b2, voffB); PG8_STAGE(PG8_SB(0, 1), b2 + hstepB, voffB); PG8_STAGE(PG8_SA(0, 0), a2, voffA);
            PG8_WAIT_V(8); PG8_WAIT_L(0); PG8_BAR; PG8_MMA(1, 0, At, B0); PG8_MMA(1, 1, At, B1); PG8_BAR; PG8_SCHED;
            PG8_LDB(B0, 1, 0); PG8_LDB(B1, 1, 1); PG8_SCHED; PG8_LDA(At, 1, 0); PG8_STAGE(PG8_SA(0, 1), a2 + hstepA, voffA);
            PG8_WAIT_V(8); PG8_WAIT_L(0); PG8_BAR; PG8_MMA(0, 0, At, B0); PG8_MMA(0, 1, At, B1); PG8_BAR; PG8_SCHED;
            PG8_LDA(At, 1, 1); PG8_STAGE(PG8_SB(1, 0), b3, voffB); PG8_STAGE(PG8_SB(1, 1), b3 + hstepB, voffB); PG8_STAGE(PG8_SA(1, 0), a3, voffA);
            PG8_WAIT_V(8); PG8_WAIT_L(0); PG8_BAR; PG8_MMA(1, 0, At, B0); PG8_MMA(1, 1, At, B1); PG8_BAR; PG8_SCHED;
        }
        if (wr == 0) PG8_BAR;
        E(acc, cur, wr, wc, fr, fq);
        if (!has_next) break;
        if (!(cur.flags & 1)) {
#pragma unroll
            for (int a = 0; a < 2; ++a)
#pragma unroll
                for (int b = 0; b < 2; ++b)
#pragma unroll
                    for (int m = 0; m < 4; ++m)
#pragma unroll
                        for (int n = 0; n < 2; ++n) acc[a][b][m][n] = (f32x4){0.f, 0.f, 0.f, 0.f};
        }
        cur = nxt; cA = nA; cB = nB; ++ui;
        if (wr == 1) PG8_BAR;
    }
    PG8_WAIT_V(0);
    PG8_BAR;
#undef PG8_SA
#undef PG8_SB
#undef PG8_STAGE
#undef PG8_LDA
#undef PG8_LDB
#undef PG8_MMA
#undef PG8_WAIT_V
#undef PG8_WAIT_L
#undef PG8_BAR
#undef PG8_SCHED
}
}
using pg8::Unit;

struct RangeSched {
    const char* A; const char* B; size_t tA, tB; int nN, n, first, G, pm0;
    __device__ __forceinline__ bool next(int i, Unit& u) const {
        const int idx = first + i * G; if (idx >= n) return false;
        const int pm = idx / nN, pn = idx - pm * nN;
        u.A = A + (size_t)pm * tA; u.B = B + (size_t)pn * tB; u.pm = pm + pm0; u.pn = pn; u.flags = 0; return true; }
};
struct MergeSched {
    const char *A0, *A1, *B0, *B1; size_t tA, tB; int n, c, G;
    __device__ __forceinline__ bool next(int i, Unit& u) const {
        const int tile = c + (i >> 1) * G; if (tile >= n) return false;
        const int seg = i & 1, pm = tile >> 2, pn = tile & 3;
        u.A = (seg ? A1 : A0) + (size_t)pm * tA; u.B = (seg ? B1 : B0) + (size_t)pn * tB; u.pm = pm; u.pn = pn; u.flags = seg ? 0 : 1; return true; }
};
__device__ __forceinline__ int first_of(int base, int c, int G) { return (((c - base) % G) + G) % G; }
__device__ __forceinline__ int key_row(int tok) { if (tok < TP) return tok; const int s = tok - TP; return TP + (s >> 12) * NKS + (s & 4095); }
__device__ __forceinline__ int cond_of(int tok) { return tok < TP ? 4 : ((tok - TP) >> 12); }

struct Ptrs {
    const float* in[24]; float* out; unsigned char* ws;
};

struct EpiIn {
    static constexpr bool PERM = true, SWAP = false;
    unsigned char* ws; float* out;
    __device__ __forceinline__ void operator()(f32x4 (&acc)[2][2][4][2], const Unit& u, int wr, int wc, int fr, int fq) const {
        const int pn = u.pn;
        float* rsq = (float*)(ws + WS_RSQ); float* rskv = (float*)(ws + WS_RSKV);
        const float* rope = (const float*)(ws + WS_ROPE); const float* lb1m = (const float*)(ws + WS_LB);
#pragma unroll
        for (int ai = 0; ai < 2; ++ai)
#pragma unroll
            for (int m = 0; m < 4; ++m) { asm volatile("" ::: "memory");
                const int row = u.pm * 256 + ai * 128 + wr * 64 + m * 16 + fr;
                if (pn == 0) {
                    const int kr = key_row(row); float ss = 0.f;
#pragma unroll
                    for (int bj = 0; bj < 2; ++bj) { const f32x4 v0 = acc[ai][bj][m][0], v1 = acc[ai][bj][m][1]; const int col = bj * 128 + wc * 32 + fq * 8;
                        ss += v0[0] * v0[0] + v0[1] * v0[1] + v0[2] * v0[2] + v0[3] * v0[3] + v1[0] * v1[0] + v1[1] * v1[1] + v1[2] * v1[2] + v1[3] * v1[3];
                        st8((bf16_t*)(ws + WS_CKVA) + (size_t)kr * 256 + col, v0, v1); }
                    ss += __shfl_xor(ss, 16); ss += __shfl_xor(ss, 32);
                    if (fq == 0) atomicAdd(rskv + kr, ss);
                } else if (pn <= 2) {
                    float ss = 0.f;
#pragma unroll
                    for (int bj = 0; bj < 2; ++bj) { const f32x4 v0 = acc[ai][bj][m][0], v1 = acc[ai][bj][m][1]; const int cb = (pn - 1) * 256 + bj * 128 + wc * 32;
                        if (cb < 384) {
                            ss += v0[0] * v0[0] + v0[1] * v0[1] + v0[2] * v0[2] + v0[3] * v0[3] + v1[0] * v1[0] + v1[1] * v1[1] + v1[2] * v1[2] + v1[3] * v1[3];
                            st8((bf16_t*)(ws + WS_QLAT) + (size_t)row * 384 + cb + fq * 8, v0, v1);
                        } else if (cb == 384) {
                            const int j0 = fq * 8; const int kr = key_row(row); bf16_t* krp = (bf16_t*)((unsigned char*)out + DO_KR) + (size_t)kr * 32 + j0;
                            if (row < TP) { float* o = out + OUT_KROPE + (size_t)row * 32 + j0; *(f32x4*)o = v0; *(f32x4*)(o + 4) = v1; st8(krp, v0, v1); }
                            else { const int pos = (row - TP) & 4095; const float* rp = rope + ((size_t)pos * 16 + fq * 4) * 2;
                                const f32x4 cs0 = *(const f32x4*)rp, cs1 = *(const f32x4*)(rp + 4);
                                f32x4 r0, r1;
                                r0[0] = v0[0] * cs0[0] - v0[1] * cs0[1]; r0[1] = v0[0] * cs0[1] + v0[1] * cs0[0];
                                r0[2] = v0[2] * cs0[2] - v0[3] * cs0[3]; r0[3] = v0[2] * cs0[3] + v0[3] * cs0[2];
                                r1[0] = v1[0] * cs1[0] - v1[1] * cs1[1]; r1[1] = v1[0] * cs1[1] + v1[1] * cs1[0];
                                r1[2] = v1[2] * cs1[2] - v1[3] * cs1[3]; r1[3] = v1[2] * cs1[3] + v1[3] * cs1[2];
                                st8(krp, r0, r1); }
                        } }
                    if (pn == 1 || true) { ss += __shfl_xor(ss, 16); ss += __shfl_xor(ss, 32); if (fq == 0 && ss != 0.f) atomicAdd(rsq + row, ss); }
                } else {
                    const int buf = (pn - 3) >> 1; bf16_t* base = (bf16_t*)(ws + WS_HQ + (size_t)buf * 24 * MiB) + (size_t)row * 512;
#pragma unroll
                    for (int bj = 0; bj < 2; ++bj) { f32x4 v0 = acc[ai][bj][m][0], v1 = acc[ai][bj][m][1]; const int col = ((pn - 3) & 1) * 256 + bj * 128 + wc * 32 + fq * 8;
                        if (buf == 0) {
#pragma unroll
                            for (int j = 0; j < 4; ++j) { v0[j] = silu(v0[j]) * 0.125f; v1[j] = silu(v1[j]) * 0.125f; }
                        } else if (buf == 1 || buf == 2) { const float* lp = lb1m + (buf - 1) * 512 + col; const f32x4 l0 = *(const f32x4*)lp, l1 = *(const f32x4*)(lp + 4);
#pragma unroll
                            for (int j = 0; j < 4; ++j) { v0[j] = l0[j] * sigm(-v0[j]); v1[j] = l1[j] * sigm(-v1[j]); }
                        } else if (buf == 4) {
#pragma unroll
                            for (int j = 0; j < 4; ++j) { v0[j] = silu(v0[j]); v1[j] = silu(v1[j]); }
                        }
                        st8(base + col, v0, v1); }
                }
            }
    }
};
struct EpiQ {
    static constexpr bool PERM = true, SWAP = false;
    unsigned char* ws; float* out;
    __device__ __forceinline__ void operator()(f32x4 (&acc)[2][2][4][2], const Unit& u, int wr, int wc, int fr, int fq) const {
        const float* rsq = (const float*)(ws + WS_RSQ); const float* rope = (const float*)(ws + WS_ROPE);
        bf16_t* Q = (bf16_t*)((unsigned char*)out + DO_Q);
#pragma unroll
        for (int ai = 0; ai < 2; ++ai)
#pragma unroll
            for (int m = 0; m < 4; ++m) { asm volatile("" ::: "memory");
                const int row = u.pm * 256 + ai * 128 + wr * 64 + m * 16 + fr;
                const float r = __builtin_amdgcn_rsqf(rsq[row] * (1.f / 384.f) + EPS) * QSCALE;
#pragma unroll
                for (int bj = 0; bj < 2; ++bj) { f32x4 v0 = acc[ai][bj][m][0] * r, v1 = acc[ai][bj][m][1] * r; const int col = u.pn * 256 + bj * 128 + wc * 32 + fq * 8;
                    const int d = col % 96;
                    if (d >= 64 && row >= TP) { const int pos = (row - TP) & 4095; const float* rp = rope + ((size_t)pos * 16 + ((d - 64) >> 1)) * 2;
                        const f32x4 cs0 = *(const f32x4*)rp, cs1 = *(const f32x4*)(rp + 4); f32x4 r0, r1;
                        r0[0] = v0[0] * cs0[0] - v0[1] * cs0[1]; r0[1] = v0[0] * cs0[1] + v0[1] * cs0[0];
                        r0[2] = v0[2] * cs0[2] - v0[3] * cs0[3]; r0[3] = v0[2] * cs0[3] + v0[3] * cs0[2];
                        r1[0] = v1[0] * cs1[0] - v1[1] * cs1[1]; r1[1] = v1[0] * cs1[1] + v1[1] * cs1[0];
                        r1[2] = v1[2] * cs1[2] - v1[3] * cs1[3]; r1[3] = v1[2] * cs1[3] + v1[3] * cs1[2];
                        v0 = r0; v1 = r1; }
                    st8(Q + (size_t)row * 768 + col, v0, v1); }
            }
    }
};
__device__ __forceinline__ bool ctx_tile(int pm) { return pm >= 32 && ((pm - 32) % 18) >= 16; }
__device__ __forceinline__ float rkv_of(const float* rskv, int kr, bool ctx) { return ctx ? 1.f : __builtin_amdgcn_rsqf(rskv[kr] * (1.f / 256.f) + EPS); }
struct EpiK {
    static constexpr bool PERM = true, SWAP = false;
    unsigned char* ws; float* out;
    __device__ __forceinline__ void operator()(f32x4 (&acc)[2][2][4][2], const Unit& u, int wr, int wc, int fr, int fq) const {
        const float* rskv = (const float*)(ws + WS_RSKV); bf16_t* Kn = (bf16_t*)((unsigned char*)out + DO_KN); const bool ctx = ctx_tile(u.pm);
#pragma unroll
        for (int ai = 0; ai < 2; ++ai)
#pragma unroll
            for (int m = 0; m < 4; ++m) { asm volatile("" ::: "memory");
                const int row = u.pm * 256 + ai * 128 + wr * 64 + m * 16 + fr; const float r = rkv_of(rskv, row, ctx);
#pragma unroll
                for (int bj = 0; bj < 2; ++bj) { const int col = u.pn * 256 + bj * 128 + wc * 32 + fq * 8; st8(Kn + (size_t)row * 512 + col, acc[ai][bj][m][0] * r, acc[ai][bj][m][1] * r); }
            }
    }
};
struct EpiV {
    static constexpr bool PERM = false, SWAP = true;
    unsigned char* ws; float* out;
    __device__ __forceinline__ void operator()(f32x4 (&acc)[2][2][4][2], const Unit& u, int wr, int wc, int fr, int fq) const {
        const float* rskv = (const float*)(ws + WS_RSKV); const bool ctx = ctx_tile(u.pm);
#pragma unroll
        for (int ai = 0; ai < 2; ++ai)
#pragma unroll
            for (int m = 0; m < 4; ++m) { asm volatile("" ::: "memory");
                const int kr = u.pm * 256 + ai * 128 + wr * 64 + m * 16 + fq * 4;
                f32x4 r4 = {1.f, 1.f, 1.f, 1.f}; if (!ctx) { r4 = *(const f32x4*)(rskv + kr); r4[0] = __builtin_amdgcn_rsqf(r4[0] * (1.f / 256.f) + EPS); r4[1] = __builtin_amdgcn_rsqf(r4[1] * (1.f / 256.f) + EPS); r4[2] = __builtin_amdgcn_rsqf(r4[2] * (1.f / 256.f) + EPS); r4[3] = __builtin_amdgcn_rsqf(r4[3] * (1.f / 256.f) + EPS); }
                const float r0 = r4[0], r1 = r4[1], r2 = r4[2], r3 = r4[3];
                bf16_t* base; int nk, key;
                if (u.pm < 32) { base = (bf16_t*)((unsigned char*)out + DO_VTP) + (size_t)u.pm * 8 * 64 * 256; nk = 256; key = kr & 255; }
                else { const int b = (u.pm - 32) / 18; base = (bf16_t*)((unsigned char*)out + DO_VTS) + (size_t)b * 8 * 64 * NKS; nk = NKS; key = kr - TP - b * NKS; }
#pragma unroll
                for (int bj = 0; bj < 2; ++bj)
#pragma unroll
                    for (int n = 0; n < 2; ++n) { const int col = u.pn * 256 + bj * 128 + wc * 32 + n * 16 + fr; const f32x4 v = acc[ai][bj][m][n];
                        u32x2 w; w.x = cvtpk(v[0] * r0, v[1] * r1); w.y = cvtpk(v[2] * r2, v[3] * r3);
                        *(u32x2*)(base + (size_t)col * nk + key) = w; }
            }
    }
};
struct EpiGate {
    static constexpr bool PERM = true, SWAP = false;
    unsigned char* ws;
    __device__ __forceinline__ void operator()(f32x4 (&acc)[2][2][4][2], const Unit& u, int wr, int wc, int fr, int fq) const {
        bf16_t* G = (bf16_t*)(ws + WS_G);
#pragma unroll
        for (int ai = 0; ai < 2; ++ai)
#pragma unroll
            for (int m = 0; m < 4; ++m) { asm volatile("" ::: "memory"); const int row = u.pm * 256 + ai * 128 + wr * 64 + m * 16 + fr;
#pragma unroll
                for (int bj = 0; bj < 2; ++bj) { f32x4 v0 = acc[ai][bj][m][0], v1 = acc[ai][bj][m][1]; const int col = u.pn * 256 + bj * 128 + wc * 32 + fq * 8;
#pragma unroll
                    for (int j = 0; j < 4; ++j) { v0[j] = sigm(v0[j]); v1[j] = sigm(v1[j]); }
                    st8(G + (size_t)row * 2048 + col, v0, v1); } }
    }
};
struct EpiMerge {
    static constexpr bool PERM = true, SWAP = false;
    unsigned char* ws;
    __device__ __forceinline__ void operator()(f32x4 (&acc)[2][2][4][2], const Unit& u, int wr, int wc, int fr, int fq) const {
        const bf16_t* G = (const bf16_t*)(ws + WS_G); bf16_t* MG = (bf16_t*)(ws + WS_MERGED);
#pragma unroll
        for (int ai = 0; ai < 2; ++ai)
#pragma unroll
            for (int m = 0; m < 4; ++m) { asm volatile("" ::: "memory"); const int row = u.pm * 256 + ai * 128 + wr * 64 + m * 16 + fr;
#pragma unroll
                for (int bj = 0; bj < 2; ++bj) { const int col = u.pn * 256 + bj * 128 + wc * 32 + fq * 8;
                    const u32x4 gb = *(const u32x4*)(G + (size_t)row * 2048 + 1024 + col);
                    f32x4 b0 = {bflo(gb.x), bfhi(gb.x), bflo(gb.y), bfhi(gb.y)}, b1 = {bflo(gb.z), bfhi(gb.z), bflo(gb.w), bfhi(gb.w)};
                    if (u.flags & 1) { const u32x4 ga = *(const u32x4*)(G + (size_t)row * 2048 + col);
                        f32x4 a0 = {bflo(ga.x), bfhi(ga.x), bflo(ga.y), bfhi(ga.y)}, a1 = {bflo(ga.z), bfhi(ga.z), bflo(ga.w), bfhi(ga.w)};
#pragma unroll
                        for (int j = 0; j < 4; ++j) { acc[ai][bj][m][0][j] *= a0[j] * __builtin_amdgcn_rcpf(fmaxf(b0[j], 1e-30f)); acc[ai][bj][m][1][j] *= a1[j] * __builtin_amdgcn_rcpf(fmaxf(b1[j], 1e-30f)); }
                    } else st8(MG + (size_t)row * 1024 + col, acc[ai][bj][m][0] * b0, acc[ai][bj][m][1] * b1); } }
    }
};
struct EpiRes {
    static constexpr bool PERM = true, SWAP = false;
    const float* xp; const float* xs; float* out; const float* gate;
    __device__ __forceinline__ void operator()(f32x4 (&acc)[2][2][4][2], const Unit& u, int wr, int wc, int fr, int fq) const {
#pragma unroll
        for (int ai = 0; ai < 2; ++ai)
#pragma unroll
            for (int m = 0; m < 4; ++m) { asm volatile("" ::: "memory"); const int row = u.pm * 256 + ai * 128 + wr * 64 + m * 16 + fr;
                const float* g = gate + (size_t)cond_of(row) * 6144;
                const float* bp = xp ? (row < TP ? xp + (size_t)row * 1024 : xs + (size_t)(row - TP) * 1024) : out + (size_t)row * 1024;
                float* op = out + (size_t)row * 1024;
#pragma unroll
                for (int bj = 0; bj < 2; ++bj) { const int col = u.pn * 256 + bj * 128 + wc * 32 + fq * 8;
                    const f32x4 g0 = *(const f32x4*)(g + col), g1 = *(const f32x4*)(g + col + 4), x0 = *(const f32x4*)(bp + col), x1 = *(const f32x4*)(bp + col + 4);
                    *(f32x4*)(op + col) = x0 + g0 * acc[ai][bj][m][0]; *(f32x4*)(op + col + 4) = x1 + g1 * acc[ai][bj][m][1]; } }
    }
};
struct EpiFF1 {
    static constexpr bool PERM = true, SWAP = false;
    unsigned char* ws; int row0;
    __device__ __forceinline__ void operator()(f32x4 (&acc)[2][2][4][2], const Unit& u, int wr, int wc, int fr, int fq) const {
        bf16_t* HID = (bf16_t*)(ws + WS_HID);
#pragma unroll
        for (int ai = 0; ai < 2; ++ai)
#pragma unroll
            for (int m = 0; m < 4; ++m) { asm volatile("" ::: "memory"); const int row = u.pm * 256 + ai * 128 + wr * 64 + m * 16 + fr - row0;
#pragma unroll
                for (int bj = 0; bj < 2; ++bj) { f32x4 v0 = acc[ai][bj][m][0], v1 = acc[ai][bj][m][1]; const int col = u.pn * 256 + bj * 128 + wc * 32 + fq * 8;
#pragma unroll
                    for (int j = 0; j < 4; ++j) { const float a = fmaxf(v0[j], 0.f), b = fmaxf(v1[j], 0.f); v0[j] = a * a; v1[j] = b * b; }
                    st8(HID + (size_t)row * 4096 + col, v0, v1); } }
    }
};

#define MFMA32(a, b, c) __builtin_amdgcn_mfma_f32_32x32x16_bf16((a), (b), (c), 0, 0, 0)
constexpr int AT_KP = 208, AT_VP = 144, AT_KB = 64 * AT_KP, AT_BUF = AT_KB + 64 * AT_VP;
__device__ __forceinline__ void attn_unit(unsigned char* sm, const bf16_t* Qg, const bf16_t* Kn, const bf16_t* KR, const bf16_t* Vt, int NK, int head, bf16_t* Og) {
    int tid_ = threadIdx.x; asm volatile("" : "+v"(tid_));
    const int tid = tid_, lane = tid & 63, wid = tid >> 6, x = lane & 31, hh = lane >> 5;
    const int sig = (x & ~12) | ((x & 4) << 1) | ((x & 8) >> 1);
    bf16x8 qf[6];
    { const bf16_t* qp = Qg + (size_t)(wid * 32 + x) * 768 + head * 96 + hh * 8;
#pragma unroll
      for (int d0 = 0; d0 < 6; ++d0) qf[d0] = *(const bf16x8*)(qp + d0 * 16); }
    const int kkey = tid >> 3, kc = tid & 7, rkey = tid >> 2, rc = tid & 3;
    const bf16_t* kp = Kn + (size_t)kkey * 512 + head * 64 + kc * 8;
    const bf16_t* rp = KR + (size_t)rkey * 32 + rc * 8;
    const bf16_t* vp = Vt + (size_t)kkey * NK + kc * 8;
    const int kdst = kkey * AT_KP + kc * 16, rdst = rkey * AT_KP + 128 + rc * 16, vdst = AT_KB + kkey * AT_VP + kc * 16;
    u32x4 gk, gr, gv;
    gk = *(const u32x4*)kp; gv = *(const u32x4*)vp; if (tid < 256) gr = *(const u32x4*)rp;
    *(u32x4*)(sm + kdst) = gk; *(u32x4*)(sm + vdst) = gv; if (tid < 256) *(u32x4*)(sm + rdst) = gr;
    __syncthreads();
    f32x16 o0 = {}, o1 = {};
    float mrun = -INFINITY, lrun = 0.f;
    const int NT = NK >> 6;
    for (int t = 0; t < NT; ++t) {
        unsigned char* cb = sm + (t & 1) * AT_BUF; unsigned char* nb = sm + ((t + 1) & 1) * AT_BUF;
        const bool more = t + 1 < NT;
        if (more) { const size_t k1 = (size_t)(t + 1) * 64; gk = *(const u32x4*)(kp + k1 * 512); gv = *(const u32x4*)(vp + k1); if (tid < 256) gr = *(const u32x4*)(rp + k1 * 32); }
        f32x16 s0 = {}, s1 = {};
        const unsigned char* ka = cb + sig * AT_KP + hh * 16;
#pragma unroll
        for (int d0 = 0; d0 < 6; ++d0) { const bf16x8 a0 = *(const bf16x8*)(ka + d0 * 32), a1 = *(const bf16x8*)(ka + 32 * AT_KP + d0 * 32);
            s0 = MFMA32(a0, qf[d0], s0); s1 = MFMA32(a1, qf[d0], s1); }
        float mx = fmaxf(s0[0], s1[0]);
#pragma unroll
        for (int i = 1; i < 16; ++i) mx = fmaxf(mx, fmaxf(s0[i], s1[i]));
        mx = fmaxf(mx, __shfl_xor(mx, 32));
        const float mn = fmaxf(mrun, mx); const float alpha = __builtin_amdgcn_exp2f(mrun - mn); mrun = mn;
        float rs = 0.f;
#pragma unroll
        for (int i = 0; i < 16; ++i) { s0[i] = __builtin_amdgcn_exp2f(s0[i] - mn); s1[i] = __builtin_amdgcn_exp2f(s1[i] - mn); rs += s0[i] + s1[i]; }
        lrun = lrun * alpha + rs;
#pragma unroll
        for (int i = 0; i < 16; ++i) { o0[i] *= alpha; o1[i] *= alpha; }
        u32x4 w00, w01, w10, w11;
        w00.x = cvtpk(s0[0], s0[1]); w00.y = cvtpk(s0[2], s0[3]); w00.z = cvtpk(s0[4], s0[5]); w00.w = cvtpk(s0[6], s0[7]);
        w01.x = cvtpk(s0[8], s0[9]); w01.y = cvtpk(s0[10], s0[11]); w01.z = cvtpk(s0[12], s0[13]); w01.w = cvtpk(s0[14], s0[15]);
        w10.x = cvtpk(s1[0], s1[1]); w10.y = cvtpk(s1[2], s1[3]); w10.z = cvtpk(s1[4], s1[5]); w10.w = cvtpk(s1[6], s1[7]);
        w11.x = cvtpk(s1[8], s1[9]); w11.y = cvtpk(s1[10], s1[11]); w11.z = cvtpk(s1[12], s1[13]); w11.w = cvtpk(s1[14], s1[15]);
        const bf16x8 p00 = __builtin_bit_cast(bf16x8, w00), p01 = __builtin_bit_cast(bf16x8, w01), p10 = __builtin_bit_cast(bf16x8, w10), p11 = __builtin_bit_cast(bf16x8, w11);
        const unsigned char* va = cb + AT_KB + x * AT_VP + hh * 16;
        o0 = MFMA32(*(const bf16x8*)(va), p00, o0); o0 = MFMA32(*(const bf16x8*)(va + 32), p01, o0);
        o0 = MFMA32(*(const bf16x8*)(va + 64), p10, o0); o0 = MFMA32(*(const bf16x8*)(va + 96), p11, o0);
        const unsigned char* vb = va + 32 * AT_VP;
        o1 = MFMA32(*(const bf16x8*)(vb), p00, o1); o1 = MFMA32(*(const bf16x8*)(vb + 32), p01, o1);
        o1 = MFMA32(*(const bf16x8*)(vb + 64), p10, o1); o1 = MFMA32(*(const bf16x8*)(vb + 96), p11, o1);
        if (more) { *(u32x4*)(nb + kdst) = gk; *(u32x4*)(nb + vdst) = gv; if (tid < 256) *(u32x4*)(nb + rdst) = gr; }
        __syncthreads();
    }
    const float ltot = lrun + __shfl_xor(lrun, 32); const float inv = 1.f / ltot;
    bf16_t* op = Og + (size_t)(wid * 32 + x) * 512 + head * 64 + hh * 4;
#pragma unroll
    for (int g = 0; g < 4; ++g) {
        u32x2 w; w.x = cvtpk(o0[4 * g] * inv, o0[4 * g + 1] * inv); w.y = cvtpk(o0[4 * g + 2] * inv, o0[4 * g + 3] * inv); *(u32x2*)(op + 8 * g) = w;
        u32x2 w2; w2.x = cvtpk(o1[4 * g] * inv, o1[4 * g + 1] * inv); w2.y = cvtpk(o1[4 * g + 2] * inv, o1[4 * g + 3] * inv); *(u32x2*)(op + 32 + 8 * g) = w2; }
    __syncthreads();
}

constexpr int HG_OF = 0, HG_PART = 65536, HG_SKK = 98304, HG_SQ = 102400, HG_SV = 106496;
__device__ __forceinline__ void hg_stage(unsigned char* sm, const bf16_t* KK, const bf16_t* HQ, const bf16_t* HI, size_t row0, int head, int tokbase, int dirsign, bool withq) {
    const int tid = threadIdx.x, s = tid >> 5, cp = tid & 31;
    const size_t off = (row0 + (size_t)(tokbase + dirsign * s)) * 512 + head * 64 + cp * 2;
    const unsigned a = *(const unsigned*)(KK + off), c = *(const unsigned*)(HI + off);
    *(f32x2*)(sm + HG_SKK + (s * 64 + cp * 2) * 4) = (f32x2){bflo(a), bfhi(a)};
    *(f32x2*)(sm + HG_SV + (s * 64 + cp * 2) * 4) = (f32x2){bflo(c), bfhi(c)};
    if (withq) { const unsigned b = *(const unsigned*)(HQ + off); *(f32x2*)(sm + HG_SQ + (s * 64 + cp * 2) * 4) = (f32x2){bflo(b), bfhi(b)}; }
}
#define HG_UPD(i, kkv, qv) { S[i] = fmaf(kkv, v - S[i], S[i]); o = fmaf(qv, S[i], o); }
__device__ __forceinline__ void hgrn_passA(unsigned char* sm, unsigned char* ws, int item) {
    int tid_ = threadIdx.x; asm volatile("" : "+v"(tid_));
    const int tid = tid_, lane = tid & 63, w = tid >> 6;
    const int sc = item & 15, dir = (item >> 4) & 1, h = (item >> 5) & 7, b = item >> 8;
    const bf16_t* KK = (const bf16_t*)(ws + (dir ? WS_KKB : WS_KKF)); const bf16_t* HI = (const bf16_t*)(ws + WS_HI);
    const size_t row0 = (size_t)TP + (size_t)b * 4096 + sc * 256;
    float S[8], D[8];
#pragma unroll
    for (int i = 0; i < 8; ++i) { S[i] = 0.f; D[i] = 1.f; }
    for (int bt = 0; bt < 16; ++bt) {
        hg_stage(sm, KK, KK, HI, row0, h, dir ? 255 - 16 * bt : 16 * bt, dir ? -1 : 1, false);
        __syncthreads();
#pragma unroll 4
        for (int s = 0; s < 16; ++s) {
            const f32x4 k0 = *(const f32x4*)(sm + HG_SKK + (s * 64 + w * 8) * 4), k1 = *(const f32x4*)(sm + HG_SKK + (s * 64 + w * 8 + 4) * 4);
            const float v = *(const float*)(sm + HG_SV + (s * 64 + lane) * 4);
#pragma unroll
            for (int i = 0; i < 4; ++i) { S[i] = fmaf(k0[i], v - S[i], S[i]); D[i] *= 1.f - k0[i]; S[4 + i] = fmaf(k1[i], v - S[4 + i], S[4 + i]); D[4 + i] *= 1.f - k1[i]; }
        }
        __syncthreads();
    }
    float* SL = (float*)(ws + WS_SL) + (size_t)item * 4096; float* DD = (float*)(ws + WS_DD) + (size_t)item * 64;
#pragma unroll
    for (int i = 0; i < 8; ++i) { SL[(w * 8 + i) * 64 + lane] = S[i]; if (lane == 0) DD[w * 8 + i] = D[i]; }
}
__device__ __forceinline__ void hgrn_passC(unsigned char* sm, unsigned char* ws, const float* state_in, const float* g_hg, float* out, bool prompt, int b, int h, int sc) {
    int tid_ = threadIdx.x; asm volatile("" : "+v"(tid_));
    const int tid = tid_, lane = tid & 63, w = tid >> 6;
    const bf16_t* HQ = (const bf16_t*)(ws + WS_HQ); const bf16_t* HI = (const bf16_t*)(ws + WS_HI); bf16_t* HG = (bf16_t*)(ws + WS_HG);
    const size_t row0 = prompt ? (size_t)b * 256 : (size_t)TP + (size_t)b * 4096 + sc * 256;
    const float gh = g_hg[h * 64 + lane];
    for (int dir = 0; dir < 2; ++dir) {
        const bf16_t* KK = (const bf16_t*)(ws + (dir ? WS_KKB : WS_KKF));
        float S[8];
        if (prompt) {
#pragma unroll
            for (int i = 0; i < 8; ++i) S[i] = 0.f;
        } else {
            const float* s0 = state_in + ((size_t)(b * 2 + dir) * 8 + h) * 4096;
#pragma unroll
            for (int i = 0; i < 8; ++i) S[i] = s0[(w * 8 + i) * 64 + lane];
            const int ibase = ((b * 8 + h) * 2 + dir) * 16;
            const int n = dir ? 15 - sc : sc;
            for (int j = 0; j < n; ++j) { const int it = ibase + (dir ? 15 - j : j);
                const float* SL = (const float*)(ws + WS_SL) + (size_t)it * 4096; const float* DD = (const float*)(ws + WS_DD) + (size_t)it * 64;
#pragma unroll
                for (int i = 0; i < 8; ++i) S[i] = fmaf(DD[w * 8 + i], S[i], SL[(w * 8 + i) * 64 + lane]); }
        }
        for (int bt = 0; bt < 16; ++bt) {
            const int tokbase = dir ? 255 - 16 * bt : 16 * bt, sgn = dir ? -1 : 1;
            hg_stage(sm, KK, HQ, HI, row0, h, tokbase, sgn, true);
            __syncthreads();
#pragma unroll 4
            for (int s = 0; s < 16; ++s) {
                const f32x4 k0 = *(const f32x4*)(sm + HG_SKK + (s * 64 + w * 8) * 4), k1 = *(const f32x4*)(sm + HG_SKK + (s * 64 + w * 8 + 4) * 4);
                const f32x4 q0 = *(const f32x4*)(sm + HG_SQ + (s * 64 + w * 8) * 4), q1 = *(const f32x4*)(sm + HG_SQ + (s * 64 + w * 8 + 4) * 4);
                const float v = *(const float*)(sm + HG_SV + (s * 64 + lane) * 4);
                float o = 0.f;
                HG_UPD(0, k0[0], q0[0]) HG_UPD(1, k0[1], q0[1]) HG_UPD(2, k0[2], q0[2]) HG_UPD(3, k0[3], q0[3])
                HG_UPD(4, k1[0], q1[0]) HG_UPD(5, k1[1], q1[1]) HG_UPD(6, k1[2], q1[2]) HG_UPD(7, k1[3], q1[3])
                *(float*)(sm + HG_PART + ((w * 16 + s) * 64 + lane) * 4) = o;
            }
            __syncthreads();
#pragma unroll
            for (int r = 0; r < 2; ++r) { const int s = w * 2 + r; const int tok = tokbase + sgn * s;
                float o = 0.f;
#pragma unroll
                for (int ww = 0; ww < 8; ++ww) o += *(const float*)(sm + HG_PART + ((ww * 16 + s) * 64 + lane) * 4);
                float* ofp = (float*)(sm + HG_OF + (tok * 64 + lane) * 4);
                if (dir == 0) *ofp = o;
                else { const float tot = *ofp + o; const float ss = wave_sum(tot * tot);
                    bf16_t* hp = HG + (row0 + tok) * 512 + h * 64 + lane;
                    const float val = tot * __builtin_amdgcn_rsqf(ss * (1.f / 64.f) + EPS) * gh * bf2f(*hp);
                    *hp = (bf16_t)(cvtpk(val, 0.f) & 0xffffu); }
            }
        }
        if (prompt) { float* so = out + OUT_STATE + ((size_t)(b * 2 + dir) * 8 + h) * 4096;
#pragma unroll
            for (int i = 0; i < 8; ++i) so[(w * 8 + i) * 64 + lane] = S[i]; }
        __syncthreads();
    }
}

__device__ __forceinline__ void conv_item(const float* W, int ldw, int srccol, const float* kscale, bf16_t* WT, int K, int n0, int k0, float* scr, int lane) {
#pragma unroll 8
    for (int i = 0; i < 32; ++i) { const int kk = 2 * i + (lane >> 5); float v = 0.f;
        if (srccol >= 0) { v = W[(size_t)(k0 + kk) * ldw + srccol + (lane & 31)]; if (kscale) v *= kscale[k0 + kk]; }
        scr[kk * 33 + (lane & 31)] = v; }
    __builtin_amdgcn_s_waitcnt(0xc07f); asm volatile("" ::: "memory");
    const int c = lane & 7;
#pragma unroll
    for (int j = 0; j < 4; ++j) { const int n = (lane >> 3) + 8 * j; const float* s = scr + (8 * c) * 33 + n;
        u32x4 o; o.x = cvtpk(s[0 * 33], s[1 * 33]); o.y = cvtpk(s[2 * 33], s[3 * 33]); o.z = cvtpk(s[4 * 33], s[5 * 33]); o.w = cvtpk(s[6 * 33], s[7 * 33]);
        *(u32x4*)(WT + (size_t)(n0 + n) * K + k0 + 8 * c) = o; }
    __builtin_amdgcn_s_waitcnt(0xc07f); asm volatile("" ::: "memory");
}
__device__ __forceinline__ void sincos_small(float xx, float& s, float& c) {
    const float n = rintf(xx * 0.636619772367581f);
    float r = fmaf(n, -1.5703125f, xx); r = fmaf(n, -4.837512969970703125e-4f, r); r = fmaf(n, -7.54978995489188e-8f, r);
    const float z = r * r;
    const float sp = r + r * z * (-1.6666654611e-1f + z * (8.3321608736e-3f + z * (-1.9515295891e-4f)));
    const float cp = 1.f - 0.5f * z + z * z * (4.166664568298827e-2f + z * (-1.388731625493765e-3f + z * 2.443315711809948e-5f));
    const int q = ((int)n) & 3;
    s = (q == 0) ? sp : (q == 1) ? cp : (q == 2) ? -sp : -cp;
    c = (q == 0) ? cp : (q == 1) ? -sp : (q == 2) ? -cp : sp;
}
__device__ __forceinline__ void modnorm_row(const float* xrow, const float* g, const float* sc, const float* sh, bf16_t* orow, int lane) {
    const f32x4* xr = (const f32x4*)xrow + lane; f32x4 v[4]; float s = 0.f;
#pragma unroll
    for (int j = 0; j < 4; ++j) { v[j] = xr[64 * j]; s += v[j][0] * v[j][0] + v[j][1] * v[j][1] + v[j][2] * v[j][2] + v[j][3] * v[j][3]; }
    const float r = __builtin_amdgcn_rsqf(wave_sum(s) * (1.f / 1024.f) + EPS);
#pragma unroll
    for (int j = 0; j < 4; ++j) { const int c = (lane + 64 * j) * 4; const f32x4 gg = *(const f32x4*)(g + c), s1 = *(const f32x4*)(sc + c), s2 = *(const f32x4*)(sh + c);
        const f32x4 y = v[j] * r * gg * (1.f + s1) + s2; u32x2 w; w.x = cvtpk(y[0], y[1]); w.y = cvtpk(y[2], y[3]); *(u32x2*)(orow + c) = w; }
}

typedef const __attribute__((address_space(4))) char* kargp_t;
__device__ __forceinline__ const float* inp(int i) {
    kargp_t kp = (kargp_t)__builtin_amdgcn_kernarg_segment_ptr();
    asm volatile("" : "+s"(kp));
    return (const float*)(*(const unsigned long long __attribute__((address_space(4)))*)(kp + i * 8));
}
#define PH_IDS int tid = threadIdx.x; asm volatile("" : "+v"(tid)); const int lane = tid & 63, wave = tid >> 6, gw = c * 8 + wave, NGW = G * 8, gt = c * 512 + tid, NGT = G * 512; (void)lane; (void)wave; (void)gw; (void)NGW; (void)gt; (void)NGT;
__global__ void __launch_bounds__(512, 2) fwd_mega(Ptrs P) {
    extern __shared__ __attribute__((aligned(16))) unsigned char lds[];
    cg::grid_group grid = cg::this_grid();
    const int c = blockIdx.x, G = gridDim.x;
    unsigned char* ws = P.ws; float* out = P.out;
    LAS unsigned char* lds3 = (LAS unsigned char*)lds;
    float* mods = (float*)(ws + WS_MODS);

#ifndef SKIP_PH0
    {
        PH_IDS
        float* rs = (float*)(ws + WS_RSQ); for (int i = gt; i < 65536; i += NGT) rs[i] = 0.f;
        float* rope = (float*)(ws + WS_ROPE);
        for (int i = gt; i < 4096 * 16; i += NGT) { const int pos = i >> 4, pr = i & 15; const float p = (pr < 8) ? (float)(pos >> 6) : (float)(pos & 63);
            const float ang = p * exp2f(-1.6609640474436813f * (float)(pr & 7)); float s, cc; sincos_small(ang, s, cc); rope[2 * i] = cc; rope[2 * i + 1] = s; }
        { const float* lg = inp(17); float* lb = (float*)(ws + WS_LB); for (int i = gt; i < 1024; i += NGT) lb[i] = 1.f / (1.f + __expf(lg[i] - lg[1024 + i])); }
        { const float* cc = inp(2); const float* gk = inp(14); bf16_t* CK = (bf16_t*)(ws + WS_CKVA);
          for (int i = gt; i < 2048 * 256 / 2; i += NGT) { const int e = i * 2, r = e >> 8, col = e & 255, b = r >> 9, j = r & 511;
              const size_t kr = (size_t)TP + (size_t)b * NKS + 4096 + j; *(unsigned*)(CK + kr * 256 + col) = cvtpk(cc[e] / gk[col], cc[e + 1] / gk[col + 1]); }
          const float* ck = inp(3); bf16_t* KRb = (bf16_t*)((unsigned char*)out + DO_KR);
          for (int i = gt; i < 2048 * 32 / 2; i += NGT) { const int e = i * 2, r = e >> 5, col = e & 31, b = r >> 9, j = r & 511;
              const size_t kr = (size_t)TP + (size_t)b * NKS + 4096 + j; *(unsigned*)(KRb + kr * 32 + col) = cvtpk(ck[e], ck[e + 1]); } }
        if (c < 96) {
            const float* wa = inp(7); const float* ba = inp(8); const float* cv = inp(5); const float* cx = inp(6);
            float a0 = 0.f, a1 = 0.f, a2 = 0.f, a3 = 0.f, a4 = 0.f; const int col = c * 64 + lane;
#pragma unroll 8
            for (int k = wave * 128; k < wave * 128 + 128; ++k) { const float wv = wa[(size_t)k * 6144 + col];
                a0 = fmaf(silu(cv[k]), wv, a0); a1 = fmaf(silu(cv[1024 + k]), wv, a1); a2 = fmaf(silu(cv[2048 + k]), wv, a2); a3 = fmaf(silu(cv[3072 + k]), wv, a3); a4 = fmaf(silu(cx[k]), wv, a4); }
            float* red = (float*)lds + 8 * 2112 + wave * 320;
            red[lane] = a0; red[64 + lane] = a1; red[128 + lane] = a2; red[192 + lane] = a3; red[256 + lane] = a4;
            __syncthreads();
            if (tid < 320) { float s = 0.f; for (int w2 = 0; w2 < 8; ++w2) s += ((float*)lds + 8 * 2112)[w2 * 320 + tid]; const int cd = tid >> 6, l2 = tid & 63; mods[cd * 6144 + c * 64 + l2] = s + ba[c * 64 + l2]; }
            __syncthreads();
        }
        float* scr = (float*)lds + wave * 2112;
        const float* w_in = inp(11);
        constexpr int I0 = 104 * 16, I1 = 64 * 16, I2 = 24 * 6, I3 = 16 * 4, I4 = 16 * 4, I5 = 32 * 8, I6 = 32 * 8, I7 = 32 * 16, I8 = 128 * 16, I9 = 32 * 64;
        constexpr int NIT = I0 + I1 + I2 + I3 + I4 + I5 + I6 + I7 + I8 + I9;
        for (int it = gw; it < NIT; it += NGW) {
            int r = it;
            if (r < I0) { const int nb = r >> 4, kb = r & 15, n = nb * 32; const int src = n < 256 ? 384 + n : n < 640 ? n - 256 : n < 672 ? n : n < 768 ? -1 : n - 96;
                conv_item(w_in, NIN, src, nullptr, (bf16_t*)(ws + WS_WIN), 1024, n, kb * 64, scr, lane); continue; } r -= I0;
            if (r < I1) { const int nb = r >> 4, kb = r & 15; conv_item(w_in, NIN, 3232 + nb * 32, nullptr, (bf16_t*)(ws + WS_WG), 1024, nb * 32, kb * 64, scr, lane); continue; } r -= I1;
            if (r < I2) { const int nb = r / 6, kb = r % 6; conv_item(inp(13), 768, nb * 32, inp(12), (bf16_t*)(ws + WS_WUQ), 384, nb * 32, kb * 64, scr, lane); continue; } r -= I2;
            if (r < I3) { const int nb = r >> 2, kb = r & 3, n = nb * 32; conv_item(inp(15), 1024, (n >> 6) * 128 + (n & 63), inp(14), (bf16_t*)(ws + WS_WUK), 256, n, kb * 64, scr, lane); continue; } r -= I3;
            if (r < I4) { const int nb = r >> 2, kb = r & 3, n = nb * 32; conv_item(inp(15), 1024, (n >> 6) * 128 + 64 + (n & 63), inp(14), (bf16_t*)(ws + WS_WUV), 256, n, kb * 64, scr, lane); continue; } r -= I4;
            if (r < I5) { const int nb = r >> 3, kb = r & 7; conv_item(inp(18), 1024, nb * 32, nullptr, (bf16_t*)(ws + WS_W1), 512, nb * 32, kb * 64, scr, lane); continue; } r -= I5;
            if (r < I6) { const int nb = r >> 3, kb = r & 7; conv_item(inp(19), 1024, nb * 32, nullptr, (bf16_t*)(ws + WS_W2), 512, nb * 32, kb * 64, scr, lane); continue; } r -= I6;
            if (r < I7) { const int nb = r >> 4, kb = r & 15; conv_item(inp(20), 1024, nb * 32, nullptr, (bf16_t*)(ws + WS_WOUT), 1024, nb * 32, kb * 64, scr, lane); continue; } r -= I7;
            if (r < I8) { const int nb = r >> 4, kb = r & 15; conv_item(inp(21), 4096, nb * 32, nullptr, (bf16_t*)(ws + WS_WFF1), 1024, nb * 32, kb * 64, scr, lane); continue; } r -= I8;
            { const int nb = r >> 6, kb = r & 63; conv_item(inp(22), 1024, nb * 32, nullptr, (bf16_t*)(ws + WS_WFF2), 4096, nb * 32, kb * 64, scr, lane); }
        }
    }
#endif
    grid.sync();
#ifndef SKIP_PH0B
    { PH_IDS
    for (int r = gw; r < T; r += NGW) { const float* md = mods + (size_t)cond_of(r) * 6144;
        modnorm_row(r < TP ? inp(0) + (size_t)r * 1024 : inp(1) + (size_t)(r - TP) * 1024, inp(9), md + 1024, md, (bf16_t*)(ws + WS_H) + (size_t)r * 1024, lane); } }
#endif
    grid.sync();
#ifndef SKIP_PH1
    { RangeSched S{(const char*)(ws + WS_H), (const char*)(ws + WS_WIN), (size_t)256 * 1024 * 2, (size_t)256 * 1024 * 2, 13, 96 * 13, c, G, 0};
      EpiIn E{ws, out}; pg8::gemm_phase(lds3, 1024, 1024, 1024, S, E); }
#endif
    grid.sync();
#ifndef SKIP_PH2
    { RangeSched SQ{(const char*)(ws + WS_QLAT), (const char*)(ws + WS_WUQ), (size_t)256 * 384 * 2, (size_t)256 * 384 * 2, 3, 288, first_of(0, c, G), G, 0};
      EpiQ EQ{ws, out}; pg8::gemm_phase(lds3, 384, 384, 384, SQ, EQ);
      RangeSched SK{(const char*)(ws + WS_CKVA), (const char*)(ws + WS_WUK), (size_t)256 * 256 * 2, (size_t)256 * 256 * 2, 2, 208, first_of(288, c, G), G, 0};
      EpiK EK{ws, out}; pg8::gemm_phase(lds3, 256, 256, 256, SK, EK);
      RangeSched SV{(const char*)(ws + WS_CKVA), (const char*)(ws + WS_WUV), (size_t)256 * 256 * 2, (size_t)256 * 256 * 2, 2, 208, first_of(496, c, G), G, 0};
      EpiV EV{ws, out}; pg8::gemm_phase(lds3, 256, 256, 256, SV, EV);
      { PH_IDS
 const bf16_t* CK = (const bf16_t*)(ws + WS_CKVA); const float* rskv = (const float*)(ws + WS_RSKV); const float* gk = inp(14);
        for (int i = gt; i < TP * 256 / 4; i += NGT) { const int e = i * 4, r = e >> 8, col = e & 255; const float rr = __builtin_amdgcn_rsqf(rskv[r] * (1.f / 256.f) + EPS);
            const u32x2 w = *(const u32x2*)(CK + e); const f32x4 g4 = *(const f32x4*)(gk + col);
            *(f32x4*)(out + OUT_CKV + e) = (f32x4){bflo(w.x) * rr * g4[0], bfhi(w.x) * rr * g4[1], bflo(w.y) * rr * g4[2], bfhi(w.y) * rr * g4[3]}; } }
      __syncthreads();
      for (int it = c; it < 1024; it += G) hgrn_passA(lds, ws, it);
    }
#endif
    grid.sync();
#ifndef SKIP_PH3
    {
        const bf16_t* Q = (const bf16_t*)((unsigned char*)out + DO_Q); const bf16_t* Kn = (const bf16_t*)((unsigned char*)out + DO_KN); const bf16_t* KRb = (const bf16_t*)((unsigned char*)out + DO_KR);
        bf16_t* OM = (bf16_t*)(ws + WS_OMLA);
        for (int u = c; u < 512; u += G) { const int b = u >> 7, h = (u >> 4) & 7, qb = u & 15; const size_t qrow = (size_t)TP + (size_t)b * 4096 + qb * 256, kr0 = (size_t)TP + (size_t)b * NKS;
            attn_unit(lds, Q + qrow * 768, Kn + kr0 * 512, KRb + kr0 * 32, (const bf16_t*)((unsigned char*)out + DO_VTS) + ((size_t)(b * 8 + h) * 64) * NKS, NKS, h, OM + qrow * 512); }
        for (int u = c; u < 256; u += G) { const int b = u >> 3, h = u & 7; const size_t qrow = (size_t)b * 256;
            attn_unit(lds, Q + qrow * 768, Kn + qrow * 512, KRb + qrow * 32, (const bf16_t*)((unsigned char*)out + DO_VTP) + ((size_t)(b * 8 + h) * 64) * 256, 256, h, OM + qrow * 512); }
        for (int u = c; u < 512; u += G) hgrn_passC(lds, ws, inp(4), inp(16), out, false, u >> 7, (u >> 4) & 7, u & 15);
        for (int u = c; u < 256; u += G) hgrn_passC(lds, ws, inp(4), inp(16), out, true, u >> 3, u & 7, 0);
    }
#endif
    grid.sync();
#ifndef SKIP_PH4A
    { RangeSched S{(const char*)(ws + WS_H), (const char*)(ws + WS_WG), (size_t)256 * 1024 * 2, (size_t)256 * 1024 * 2, 8, 768, c, G, 0};
      EpiGate E{ws}; pg8::gemm_phase(lds3, 1024, 1024, 1024, S, E); }
#endif
    grid.sync();
#ifndef SKIP_PH4B
    { MergeSched S{(const char*)(ws + WS_OMLA), (const char*)(ws + WS_HG), (const char*)(ws + WS_W1), (const char*)(ws + WS_W2), (size_t)256 * 512 * 2, (size_t)256 * 512 * 2, 384, c, G};
      EpiMerge E{ws}; pg8::gemm_phase(lds3, 512, 512, 512, S, E); }
#endif
    grid.sync();
#ifndef SKIP_PH5
    { RangeSched S{(const char*)(ws + WS_MERGED), (const char*)(ws + WS_WOUT), (size_t)256 * 1024 * 2, (size_t)256 * 1024 * 2, 4, 384, c, G, 0};
      EpiRes E{inp(0), inp(1), out, mods + 2 * 1024}; pg8::gemm_phase(lds3, 1024, 1024, 1024, S, E); }
#endif
    grid.sync();
#ifndef SKIP_PH5B
    { PH_IDS
    for (int r = gw; r < T; r += NGW) { const float* md = mods + (size_t)cond_of(r) * 6144;
        modnorm_row(out + (size_t)r * 1024, inp(10), md + 4 * 1024, md + 3 * 1024, (bf16_t*)(ws + WS_H2) + (size_t)r * 1024, lane); } }
#endif
    grid.sync();
#ifndef SKIP_PH67
#pragma unroll
    for (int hf = 0; hf < 2; ++hf) {
        { RangeSched S{(const char*)(ws + WS_H2) + (size_t)hf * 12288 * 1024 * 2, (const char*)(ws + WS_WFF1), (size_t)256 * 1024 * 2, (size_t)256 * 1024 * 2, 16, 768, c, G, hf * 48};
          EpiFF1 E{ws, hf * 12288}; pg8::gemm_phase(lds3, 1024, 1024, 1024, S, E); }
        grid.sync();
        { RangeSched S{(const char*)(ws + WS_HID), (const char*)(ws + WS_WFF2), (size_t)256 * 4096 * 2, (size_t)256 * 4096 * 2, 4, 192, c, G, hf * 48};
          EpiRes E{nullptr, nullptr, out, mods + 5 * 1024}; pg8::gemm_phase(lds3, 4096, 4096, 4096, S, E); }
        grid.sync();
    }
#endif
#ifndef SKIP_PH8
    { PH_IDS
      const float* gf = inp(23);
      for (int r = gw; r < T; r += NGW) { f32x4* xr = (f32x4*)(out + (size_t)r * 1024) + lane; f32x4 v[4]; float s = 0.f;
#pragma unroll
          for (int j = 0; j < 4; ++j) { v[j] = xr[64 * j]; s += v[j][0] * v[j][0] + v[j][1] * v[j][1] + v[j][2] * v[j][2] + v[j][3] * v[j][3]; }
          const float rr = __builtin_amdgcn_rsqf(wave_sum(s) * (1.f / 1024.f) + EPS);
#pragma unroll
          for (int j = 0; j < 4; ++j) xr[64 * j] = v[j] * rr * *(const f32x4*)(gf + (lane + 64 * j) * 4); } }
#endif
}

extern "C" void kernel_launch(void* const* d_in, const int* in_sizes, int n_in, void* d_out, int out_size, void* d_ws, size_t ws_size, hipStream_t stream) {
    static int grid = 0;
    if (grid == 0) {
        int dev = 0, cus = 0, per_cu = 0;
        hipGetDevice(&dev); hipDeviceGetAttribute(&cus, hipDeviceAttributeMultiprocessorCount, dev);
        hipFuncSetAttribute((const void*)fwd_mega, hipFuncAttributeMaxDynamicSharedMemorySize, LDS_BYTES);
        hipOccupancyMaxActiveBlocksPerMultiprocessor(&per_cu, (const void*)fwd_mega, 512, LDS_BYTES);
        if (per_cu < 1) { fprintf(stderr, "kernel_launch: occupancy query says %d blocks per CU\n", per_cu); per_cu = 1; }
        grid = cus;
        if (grid > 256) grid = 256;
        (void)hipGetLastError();
    }
    Ptrs p{};
    for (int i = 0; i < 24; ++i) p.in[i] = (const float*)d_in[i];
    p.out = (float*)d_out; p.ws = (unsigned char*)d_ws;
    void* args[] = {&p};
    hipError_t e = hipLaunchCooperativeKernel((const void*)fwd_mega, dim3(grid), dim3(512), args, LDS_BYTES, stream);
    if (e != hipSuccess) fprintf(stderr, "cooperative launch failed: %s (grid %d)\n", hipGetErrorString(e), grid);
}
```

```cpp
#include <hip/hip_runtime.h>
#include <hip/hip_cooperative_groups.h>
#include <cstdint>
#include <cstdio>
namespace cg = cooperative_groups;

#define LAS __attribute__((address_space(3)))
typedef unsigned short bf16_t;
typedef short bf16x8 __attribute__((ext_vector_type(8)));
typedef float f32x4 __attribute__((ext_vector_type(4)));
typedef float f32x2 __attribute__((ext_vector_type(2)));
typedef float f32x16 __attribute__((ext_vector_type(16)));
typedef unsigned u32x4 __attribute__((ext_vector_type(4)));
typedef unsigned u32x2 __attribute__((ext_vector_type(2)));
typedef __bf16 bf16x2_t __attribute__((ext_vector_type(2)));

constexpr int DM = 1024, TP = 8192, TSM = 16384, T = 24576, KRN = 26624, NKS = 4608, NIN = 5280;
constexpr float EPS = 1e-6f;
constexpr float QSCALE = 0.10206207261596575f * 1.4426950408889634f;
constexpr size_t MiB = 1u << 20;
constexpr size_t WS_RSQ = 0, WS_RSKV = 128 * 1024, WS_MODS = 256 * 1024, WS_LB = 384 * 1024, WS_ROPE = 512 * 1024;
constexpr size_t WS_BAR = 1 * MiB;
constexpr size_t WS_WIN = 2 * MiB, WS_WG = WS_WIN + (size_t)3328 * 1024 * 2, WS_WUQ = WS_WG + 4 * MiB, WS_WUK = 13 * MiB + 256 * 1024, WS_WUV = 13 * MiB + 512 * 1024;
constexpr size_t WS_W1 = 14 * MiB, WS_W2 = 15 * MiB, WS_WOUT = 16 * MiB, WS_WFF1 = 18 * MiB, WS_WFF2 = 26 * MiB;
constexpr size_t WS_H = 34 * MiB, WS_QLAT = 82 * MiB, WS_CKVA = 100 * MiB, WS_OMLA = 82 * MiB;
constexpr size_t WS_HQ = 113 * MiB, WS_KKF = 137 * MiB, WS_KKB = 161 * MiB, WS_HI = 185 * MiB, WS_HG = 209 * MiB, WS_SL = 233 * MiB, WS_DD = 249 * MiB;
constexpr size_t WS_G = 113 * MiB, WS_MERGED = 34 * MiB, WS_H2 = 82 * MiB, WS_HID = 130 * MiB;
constexpr size_t DO_Q = 0, DO_KN = 36 * MiB, DO_KR = 62 * MiB, DO_VTP = 64 * MiB, DO_VTS = 72 * MiB;
constexpr size_t OUT_CKV = 25165824, OUT_KROPE = 27262976, OUT_STATE = 27525120;
constexpr int LDS_BYTES = 147456;

__device__ __forceinline__ unsigned cvtpk(float lo, float hi) { f32x2 v = {lo, hi}; bf16x2_t b = __builtin_convertvector(v, bf16x2_t); return __builtin_bit_cast(unsigned, b); }
__device__ __forceinline__ float bf2f(unsigned short b) { return __uint_as_float(((unsigned)b) << 16); }
__device__ __forceinline__ float bflo(unsigned w) { return __uint_as_float(w << 16); }
__device__ __forceinline__ float bfhi(unsigned w) { return __uint_as_float(w & 0xffff0000u); }
__device__ __forceinline__ void st8(bf16_t* p, f32x4 a, f32x4 b) { u32x4 w; w.x = cvtpk(a[0], a[1]); w.y = cvtpk(a[2], a[3]); w.z = cvtpk(b[0], b[1]); w.w = cvtpk(b[2], b[3]); *(u32x4*)p = w; }
__device__ __forceinline__ float sigm(float v) { return __builtin_amdgcn_rcpf(1.f + __expf(-v)); }
__device__ __forceinline__ float silu(float v) { return v * sigm(v); }
__device__ __forceinline__ float wave_sum(float v) {
#pragma unroll
    for (int o = 1; o < 64; o <<= 1) v += __shfl_xor(v, o);
    return v;
}


#define XB_TMO      128
#define XB_XCNT(j)  (256  + 64 * (j))
#define XB_XSUB(j)  (1280 + 64 * (j))
#define XB_XGEN(j)  (2304 + 64 * (j))
#define XB_TOP      3328
#define XB_TOPGEN   3392
#define XCD_BAR_WORDS 3456
#define XB_SPIN_CAP (1u << 18)
__device__ __forceinline__ unsigned xb_ld(unsigned* p)              { return __hip_atomic_load(p, __ATOMIC_RELAXED, __HIP_MEMORY_SCOPE_AGENT); }
__device__ __forceinline__ unsigned xb_add(unsigned* p, unsigned v) { return __hip_atomic_fetch_add(p, v, __ATOMIC_RELAXED, __HIP_MEMORY_SCOPE_AGENT); }
__device__ __forceinline__ unsigned xb_xcc_id() { return (unsigned)__builtin_amdgcn_s_getreg((3 << 11) | 20) & 0xFu; }
#define XB_SPIN(cond, bar) do { unsigned _sp = 0; while (cond) { __builtin_amdgcn_s_sleep(1); \
    if ((++_sp & 255u) == 0u) { if (xb_ld(&(bar)[XB_TMO])) break; if (_sp > XB_SPIN_CAP) { atomicAdd(&(bar)[XB_TMO], 1u); break; } } } } while (0)
struct XcdBarrier { unsigned* bar; unsigned x; volatile LAS unsigned* st; };
__device__ __forceinline__ XcdBarrier xcd_barrier_post(unsigned* bar, volatile LAS unsigned* st) {
    XcdBarrier b; b.bar = bar; b.x = xb_xcc_id(); b.st = st;
    if (threadIdx.x == 0) (void)xb_add(&bar[XB_XCNT(b.x)], 1u);
    return b;
}
__device__ __forceinline__ void xcd_barrier_complete(unsigned* bar, unsigned x, unsigned& nloc, unsigned& nx) {
    const unsigned G = gridDim.x * gridDim.y * gridDim.z;
    unsigned sum, cnt, mine, sp = 0u;
    for (;;) {
        sum = 0u; cnt = 0u; mine = 0u;
#pragma unroll
        for (unsigned j = 0; j < 16; ++j) { const unsigned c = xb_ld(&bar[XB_XCNT(j)]); sum += c; cnt += (c > 0u) ? 1u : 0u; mine = (j == x) ? c : mine; }
        if (sum == G) break;
        __builtin_amdgcn_s_sleep(1);
        if ((++sp & 255u) == 0u) { if (xb_ld(&bar[XB_TMO])) break; if (sp > XB_SPIN_CAP) { atomicAdd(&bar[XB_TMO], 1u); break; } }
    }
    nloc = mine > 0u ? mine : 1u; nx = cnt > 0u ? cnt : 1u;
}
__device__ __forceinline__ void xcd_barrier(const XcdBarrier& b) {
    asm volatile("s_waitcnt vmcnt(0)" ::: "memory");
    __syncthreads();
    if (threadIdx.x == 0) {
        unsigned* bar = b.bar;
        __builtin_amdgcn_s_waitcnt(0);
        unsigned nloc = b.st[0], nx = b.st[1];
        if (nloc == 0u) { xcd_barrier_complete(bar, b.x, nloc, nx); b.st[0] = nloc; b.st[1] = nx; }
        const unsigned old = xb_add(&bar[XB_XSUB(b.x)], 1u);
        const unsigned gen = old / nloc;
        if (old + 1u == (gen + 1u) * nloc) {
            __builtin_amdgcn_fence(__ATOMIC_RELEASE, "agent");
            asm volatile("s_waitcnt vmcnt(0)" ::: "memory");
            const unsigned og = xb_add(&bar[XB_TOP], 1u);
            const unsigned tg = og / nx;
            if (og + 1u == (tg + 1u) * nx) xb_add(&bar[XB_TOPGEN], 1u);
            else XB_SPIN(xb_ld(&bar[XB_TOPGEN]) == tg, bar);
            __builtin_amdgcn_fence(__ATOMIC_ACQUIRE, "agent");
            xb_add(&bar[XB_XGEN(b.x)], 1u);
            asm volatile("s_waitcnt vmcnt(0)" ::: "memory");
        } else {
            XB_SPIN(xb_ld(&bar[XB_XGEN(b.x)]) == gen, bar);
            __builtin_amdgcn_fence(__ATOMIC_ACQUIRE, "agent");
            asm volatile("s_waitcnt vmcnt(0)" ::: "memory");
        }
    }
    __syncthreads();
}

namespace pg8 {
constexpr int BM = 256, BK = 64, HALF = 128, HTB = HALF * BK * 2, STAGE_BYTES = 8 * HTB;
__host__ __device__ __forceinline__ int lds_byte(int r, int c) { const int st = (r >> 4) * 2 + (c >> 5), rr = r & 15, cc = c & 31, ob = rr * 64 + cc * 2; return st * 1024 + (ob ^ (((ob >> 9) & 1) << 5)); }
__host__ __device__ __forceinline__ void stage_rc(int b, int& R, int& C) { const int st = b / 1024, sb = b % 1024, swz = sb ^ (((sb >> 9) & 1) << 5); R = (st >> 1) * 16 + swz / 64; C = (st & 1) * 32 + (swz % 64) / 2; }
__host__ __device__ __forceinline__ int perm32(int rho) { const int n = rho >> 4, i = rho & 15; return 8 * (i >> 2) + 4 * n + (i & 3); }
struct Unit { const char* A; const char* B; int pm, pn, flags; };

template <class Epi, class Sched>
__device__ __forceinline__ void gemm_phase(LAS unsigned char* lds, const int lda, const int ldb, const int K, const Sched& S, const Epi& E) {
    int tid_ = threadIdx.x; asm volatile("" : "+v"(tid_));
    const int tid = tid_, wid = __builtin_amdgcn_readfirstlane(tid >> 6), lane = tid & 63, wr = wid >> 2, wc = wid & 3, fr = lane & 15, fq = lane >> 4;
    const int nt = K / BK;
    unsigned voffA[2], voffB[2];
#pragma unroll
    for (int i = 0; i < 2; ++i) { int R, C; stage_rc(tid * 16 + i * 8192, R, C); const int Rb = Epi::PERM ? ((R & ~31) + perm32(R & 31)) : R;
        voffA[i] = (unsigned)(R * lda + C) * 2u; voffB[i] = (unsigned)(Rb * ldb + C) * 2u; }
    const size_t kstep = (size_t)(BK * 2);
    const size_t hstepA = (size_t)HALF * lda * 2, hstepB = (size_t)HALF * ldb * 2;
    const unsigned ldsw = (unsigned)wid * 1024u;
    const int aoff = lds_byte(wr * 64 + fr, fq * 8), boff = lds_byte(wc * 32 + fr, fq * 8);
#define PG8_SA(b, h) (((b) * 2 + (h)) * HTB)
#define PG8_SB(b, h) ((4 + (b) * 2 + (h)) * HTB)
#define PG8_STAGE(bufoff, gbase, voff) do { _Pragma("unroll") for (int _i = 0; _i < 2; ++_i) \
        __builtin_amdgcn_global_load_lds((const unsigned*)((const char*)(gbase) + (voff)[_i]), (LAS unsigned*)(lds + (bufoff) + ldsw + _i * 8192), 16, 0, 0); } while (0)
#define PG8_LDA(dst, b, h) do { _Pragma("unroll") for (int m = 0; m < 4; ++m) _Pragma("unroll") for (int k = 0; k < 2; ++k) dst[m][k] = *(const LAS bf16x8*)(lds + PG8_SA(b, h) + aoff + m * 2048 + k * 1024); } while (0)
#define PG8_LDB(dst, b, h) do { _Pragma("unroll") for (int n = 0; n < 2; ++n) _Pragma("unroll") for (int k = 0; k < 2; ++k) dst[n][k] = *(const LAS bf16x8*)(lds + PG8_SB(b, h) + boff + n * 2048 + k * 1024); } while (0)
#define PG8_MMA(ai, bj, At, Bt) do { __builtin_amdgcn_s_setprio(1); _Pragma("unroll") for (int m = 0; m < 4; ++m) _Pragma("unroll") for (int n = 0; n < 2; ++n) _Pragma("unroll") for (int k = 0; k < 2; ++k) \
        acc[ai][bj][m][n] = Epi::SWAP ? __builtin_amdgcn_mfma_f32_16x16x32_bf16(At[m][k], Bt[n][k], acc[ai][bj][m][n], 0, 0, 0) \
                                      : __builtin_amdgcn_mfma_f32_16x16x32_bf16(Bt[n][k], At[m][k], acc[ai][bj][m][n], 0, 0, 0); __builtin_amdgcn_s_setprio(0); } while (0)
#define PG8_WAIT_V(n) asm volatile("s_waitcnt vmcnt(" #n ")" ::: "memory")
#define PG8_WAIT_L(n) asm volatile("s_waitcnt lgkmcnt(" #n ")" ::: "memory")
#define PG8_BAR __builtin_amdgcn_s_barrier()
#define PG8_SCHED __builtin_amdgcn_sched_barrier(0)
    Unit cur, nxt; int ui = 0;
    if (!S.next(0, cur)) return;
    f32x4 acc[2][2][4][2];
#pragma unroll
    for (int a = 0; a < 2; ++a)
#pragma unroll
        for (int b = 0; b < 2; ++b)
#pragma unroll
            for (int m = 0; m < 4; ++m)
#pragma unroll
                for (int n = 0; n < 2; ++n) acc[a][b][m][n] = (f32x4){0.f, 0.f, 0.f, 0.f};
    bf16x8 At[4][2], B0[2][2], B1[2][2];
    const char* cA = cur.A; const char* cB = cur.B;
    PG8_STAGE(PG8_SB(0, 0), cB, voffB); PG8_STAGE(PG8_SB(0, 1), cB + hstepB, voffB); PG8_STAGE(PG8_SA(0, 0), cA, voffA); PG8_STAGE(PG8_SA(0, 1), cA + hstepA, voffA);
    if (wr == 1) PG8_BAR;
    PG8_WAIT_V(2); PG8_BAR;
    PG8_STAGE(PG8_SB(1, 0), cB + kstep, voffB); PG8_STAGE(PG8_SA(1, 0), cA + kstep, voffA); PG8_STAGE(PG8_SB(1, 1), cB + hstepB + kstep, voffB);
    PG8_WAIT_V(6); PG8_BAR;
    for (;;) {
        const bool has_next = S.next(ui + 1, nxt);
        const char* nA = has_next ? nxt.A : cA; const char* nB = has_next ? nxt.B : cB;
#pragma unroll 1
        for (int t = 0; t < nt; t += 2) {
            const bool last = (t == nt - 2);
            const char* a1 = cA + (size_t)(t + 1) * kstep;
            const char* a2 = last ? nA : cA + (size_t)(t + 2) * kstep; const char* b2 = last ? nB : cB + (size_t)(t + 2) * kstep;
            const char* a3 = a2 + kstep; const char* b3 = b2 + kstep;
            PG8_LDB(B0, 0, 0); PG8_LDB(B1, 0, 1); PG8_SCHED; PG8_LDA(At, 0, 0); PG8_STAGE(PG8_SA(1, 1), a1 + hstepA, voffA);
            PG8_WAIT_V(8); PG8_WAIT_L(0); PG8_BAR; PG8_MMA(0, 0, At, B0); PG8_MMA(0, 1, At, B1); PG8_BAR; PG8_SCHED;
            PG8_LDA(At, 0, 1); PG8_STAGE(PG8_SB(0, 0), b2, voffB); PG8_STAGE(PG8_SB(0, 1), b2 + hstepB, voffB); PG8_STAGE(PG8_SA(0, 0), a2, voffA);
            PG8_WAIT_V(8); PG8_WAIT_L(0); PG8_BAR; PG8_MMA(1, 0, At, B0); PG8_MMA(1, 1, At, B1); PG8_BAR; PG8_SCHED;
            PG8_LDB(B0, 1, 0); PG8_LDB(B1, 1, 1); PG8_SCHED; PG8_LDA(At, 1, 0); PG8_STAGE(PG8_SA(0, 1), a2 + hstepA, voffA);
            PG8_WAIT_V(8); PG8_WAIT_L(0); PG8_BAR; PG8_MMA(0, 0, At, B0); PG8_MMA(0, 1, At, B1); PG8_BAR; PG8_SCHED;
            PG8_LDA(At, 1, 1); PG8_STAGE(PG8_SB(1, 0), b3, voffB); PG8_STAGE(PG8_SB(1, 1), b3 + hstepB, voffB); PG8_STAGE(PG8_SA(1, 0), a3, voffA);
            PG8_WAIT_V(8); PG8_WAIT_L(0); PG8_BAR; PG8_MMA(1, 0, At, B0); PG8_MMA(1, 1, At, B1); PG8_BAR; PG8_SCHED;
        }
        if (wr == 0) PG8_BAR;
        E(acc, cur, wr, wc, fr, fq);
        if (!has_next) break;
        if (!(cur.flags & 1)) {
#pragma unroll
            for (int a = 0; a < 2; ++a)
#pragma unroll
                for (int b = 0; b < 2; ++b)
#pragma unroll
                    for (int m = 0; m < 4; ++m)
#pragma unroll
                        for (int n = 0; n < 2; ++n) acc[a][b][m][n] = (f32x4){0.f, 0.f, 0.f, 0.f};
        }
        cur = nxt; cA = nA; cB = nB; ++ui;
        if (wr == 1) PG8_BAR;
    }
    PG8_WAIT_V(0);
    PG8_BAR;
#undef PG8_SA
#undef PG8_SB
#undef PG8_STAGE
#undef PG8_LDA
#undef PG8_LDB
#undef PG8_MMA
#undef PG8_WAIT_V
#undef PG8_WAIT_L
#undef PG8_BAR
#undef PG8_SCHED
}
}
using pg8::Unit;

struct RangeSched {
    const char* A; const char* B; size_t tA, tB; int nN, n, first, G, pm0;
    __device__ __forceinline__ bool next(int i, Unit& u) const {
        const int idx = first + i * G; if (idx >= n) return false;
        const int pm = idx / nN, pn = idx - pm * nN;
        u.A = A + (size_t)pm * tA; u.B = B + (size_t)pn * tB; u.pm = pm + pm0; u.pn = pn; u.flags = 0; return true; }
};
struct MergeSched {
    const char *A0, *A1, *B0, *B1; size_t tA, tB; int n, c, G;
    __device__ __forceinline__ bool next(int i, Unit& u) const {
        const int tile = c + (i >> 1) * G; if (tile >= n) return false;
        const int seg = i & 1, pm = tile >> 2, pn = tile & 3;
        u.A = (seg ? A1 : A0) + (size_t)pm * tA; u.B = (seg ? B1 : B0) + (size_t)pn * tB; u.pm = pm; u.pn = pn; u.flags = seg ? 0 : 1; return true; }
};
__device__ __forceinline__ int first_of(int base, int c, int G) { return (((c - base) % G) + G) % G; }
__device__ __forceinline__ int key_row(int tok) { if (tok < TP) return tok; const int s = tok - TP; return TP + (s >> 12) * NKS + (s & 4095); }
__device__ __forceinline__ int cond_of(int tok) { return tok < TP ? 4 : ((tok - TP) >> 12); }

struct Ptrs {
    const float* in[24]; float* out; unsigned char* ws;
};

struct EpiIn {
    static constexpr bool PERM = true, SWAP = false;
    unsigned char* ws; float* out;
    __device__ __forceinline__ void operator()(f32x4 (&acc)[2][2][4][2], const Unit& u, int wr, int wc, int fr, int fq) const {
        const int pn = u.pn;
        float* rsq = (float*)(ws + WS_RSQ); float* rskv = (float*)(ws + WS_RSKV);
        const float* rope = (const float*)(ws + WS_ROPE); const float* lb1m = (const float*)(ws + WS_LB);
#pragma unroll
        for (int ai = 0; ai < 2; ++ai)
#pragma unroll
            for (int m = 0; m < 4; ++m) { asm volatile("" ::: "memory");
                const int row = u.pm * 256 + ai * 128 + wr * 64 + m * 16 + fr;
                if (pn == 0) {
                    const int kr = key_row(row); float ss = 0.f;
#pragma unroll
                    for (int bj = 0; bj < 2; ++bj) { const f32x4 v0 = acc[ai][bj][m][0], v1 = acc[ai][bj][m][1]; const int col = bj * 128 + wc * 32 + fq * 8;
                        ss += v0[0] * v0[0] + v0[1] * v0[1] + v0[2] * v0[2] + v0[3] * v0[3] + v1[0] * v1[0] + v1[1] * v1[1] + v1[2] * v1[2] + v1[3] * v1[3];
                        st8((bf16_t*)(ws + WS_CKVA) + (size_t)kr * 256 + col, v0, v1); }
                    ss += __shfl_xor(ss, 16); ss += __shfl_xor(ss, 32);
                    if (fq == 0) atomicAdd(rskv + kr, ss);
                } else if (pn <= 2) {
                    float ss = 0.f;
#pragma unroll
                    for (int bj = 0; bj < 2; ++bj) { const f32x4 v0 = acc[ai][bj][m][0], v1 = acc[ai][bj][m][1]; const int cb = (pn - 1) * 256 + bj * 128 + wc * 32;
                        if (cb < 384) {
                            ss += v0[0] * v0[0] + v0[1] * v0[1] + v0[2] * v0[2] + v0[3] * v0[3] + v1[0] * v1[0] + v1[1] * v1[1] + v1[2] * v1[2] + v1[3] * v1[3];
                            st8((bf16_t*)(ws + WS_QLAT) + (size_t)row * 384 + cb + fq * 8, v0, v1);
                        } else if (cb == 384) {
                            const int j0 = fq * 8; const int kr = key_row(row); bf16_t* krp = (bf16_t*)((unsigned char*)out + DO_KR) + (size_t)kr * 32 + j0;
                            if (row < TP) { float* o = out + OUT_KROPE + (size_t)row * 32 + j0; *(f32x4*)o = v0; *(f32x4*)(o + 4) = v1; st8(krp, v0, v1); }
                            else { const int pos = (row - TP) & 4095; const float* rp = rope + ((size_t)pos * 16 + fq * 4) * 2;
                                const f32x4 cs0 = *(const f32x4*)rp, cs1 = *(const f32x4*)(rp + 4);
                                f32x4 r0, r1;
                                r0[0] = v0[0] * cs0[0] - v0[1] * cs0[1]; r0[1] = v0[0] * cs0[1] + v0[1] * cs0[0];
                                r0[2] = v0[2] * cs0[2] - v0[3] * cs0[3]; r0[3] = v0[2] * cs0[3] + v0[3] * cs0[2];
                                r1[0] = v1[0] * cs1[0] - v1[1] * cs1[1]; r1[1] = v1[0] * cs1[1] + v1[1] * cs1[0];
                                r1[2] = v1[2] * cs1[2] - v1[3] * cs1[3]; r1[3] = v1[2] * cs1[3] + v1[3] * cs1[2];
                                st8(krp, r0, r1); }
                        } }
                    if (pn == 1 || true) { ss += __shfl_xor(ss, 16); ss += __shfl_xor(ss, 32); if (fq == 0 && ss != 0.f) atomicAdd(rsq + row, ss); }
                } else {
                    const int buf = (pn - 3) >> 1; bf16_t* base = (bf16_t*)(ws + WS_HQ + (size_t)buf * 24 * MiB) + (size_t)row * 512;
#pragma unroll
                    for (int bj = 0; bj < 2; ++bj) { f32x4 v0 = acc[ai][bj][m][0], v1 = acc[ai][bj][m][1]; const int col = ((pn - 3) & 1) * 256 + bj * 128 + wc * 32 + fq * 8;
                        if (buf == 0) {
#pragma unroll
                            for (int j = 0; j < 4; ++j) { v0[j] = silu(v0[j]) * 0.125f; v1[j] = silu(v1[j]) * 0.125f; }
                        } else if (buf == 1 || buf == 2) { const float* lp = lb1m + (buf - 1) * 512 + col; const f32x4 l0 = *(const f32x4*)lp, l1 = *(const f32x4*)(lp + 4);
#pragma unroll
                            for (int j = 0; j < 4; ++j) { v0[j] = l0[j] * sigm(-v0[j]); v1[j] = l1[j] * sigm(-v1[j]); }
                        } else if (buf == 4) {
#pragma unroll
                            for (int j = 0; j < 4; ++j) { v0[j] = silu(v0[j]); v1[j] = silu(v1[j]); }
                        }
                        st8(base + col, v0, v1); }
                }
            }
    }
};
struct EpiQ {
    static constexpr bool PERM = true, SWAP = false;
    unsigned char* ws; float* out;
    __device__ __forceinline__ void operator()(f32x4 (&acc)[2][2][4][2], const Unit& u, int wr, int wc, int fr, int fq) const {
        const float* rsq = (const float*)(ws + WS_RSQ); const float* rope = (const float*)(ws + WS_ROPE);
        bf16_t* Q = (bf16_t*)((unsigned char*)out + DO_Q);
#pragma unroll
        for (int ai = 0; ai < 2; ++ai)
#pragma unroll
            for (int m = 0; m < 4; ++m) { asm volatile("" ::: "memory");
                const int row = u.pm * 256 + ai * 128 + wr * 64 + m * 16 + fr;
                const float r = __builtin_amdgcn_rsqf(rsq[row] * (1.f / 384.f) + EPS) * QSCALE;
#pragma unroll
                for (int bj = 0; bj < 2; ++bj) { f32x4 v0 = acc[ai][bj][m][0] * r, v1 = acc[ai][bj][m][1] * r; const int col = u.pn * 256 + bj * 128 + wc * 32 + fq * 8;
                    const int d = col % 96;
                    if (d >= 64 && row >= TP) { const int pos = (row - TP) & 4095; const float* rp = rope + ((size_t)pos * 16 + ((d - 64) >> 1)) * 2;
                        const f32x4 cs0 = *(const f32x4*)rp, cs1 = *(const f32x4*)(rp + 4); f32x4 r0, r1;
                        r0[0] = v0[0] * cs0[0] - v0[1] * cs0[1]; r0[1] = v0[0] * cs0[1] + v0[1] * cs0[0];
                        r0[2] = v0[2] * cs0[2] - v0[3] * cs0[3]; r0[3] = v0[2] * cs0[3] + v0[3] * cs0[2];
                        r1[0] = v1[0] * cs1[0] - v1[1] * cs1[1]; r1[1] = v1[0] * cs1[1] + v1[1] * cs1[0];
                        r1[2] = v1[2] * cs1[2] - v1[3] * cs1[3]; r1[3] = v1[2] * cs1[3] + v1[3] * cs1[2];
                        v0 = r0; v1 = r1; }
                    st8(Q + (size_t)row * 768 + col, v0, v1); }
            }
    }
};
__device__ __forceinline__ bool ctx_tile(int pm) { return pm >= 32 && ((pm - 32) % 18) >= 16; }
__device__ __forceinline__ float rkv_of(const float* rskv, int kr, bool ctx) { return ctx ? 1.f : __builtin_amdgcn_rsqf(rskv[kr] * (1.f / 256.f) + EPS); }
struct EpiK {
    static constexpr bool PERM = true, SWAP = false;
    unsigned char* ws; float* out;
    __device__ __forceinline__ void operator()(f32x4 (&acc)[2][2][4][2], const Unit& u, int wr, int wc, int fr, int fq) const {
        const float* rskv = (const float*)(ws + WS_RSKV); bf16_t* Kn = (bf16_t*)((unsigned char*)out + DO_KN); const bool ctx = ctx_tile(u.pm);
#pragma unroll
        for (int ai = 0; ai < 2; ++ai)
#pragma unroll
            for (int m = 0; m < 4; ++m) { asm volatile("" ::: "memory");
                const int row = u.pm * 256 + ai * 128 + wr * 64 + m * 16 + fr; const float r = rkv_of(rskv, row, ctx);
#pragma unroll
                for (int bj = 0; bj < 2; ++bj) { const int col = u.pn * 256 + bj * 128 + wc * 32 + fq * 8; st8(Kn + (size_t)row * 512 + col, acc[ai][bj][m][0] * r, acc[ai][bj][m][1] * r); }
            }
    }
};
struct EpiV {
    static constexpr bool PERM = false, SWAP = true;
    unsigned char* ws; float* out;
    __device__ __forceinline__ void operator()(f32x4 (&acc)[2][2][4][2], const Unit& u, int wr, int wc, int fr, int fq) const {
        const float* rskv = (const float*)(ws + WS_RSKV); const bool ctx = ctx_tile(u.pm);
#pragma unroll
        for (int ai = 0; ai < 2; ++ai)
#pragma unroll
            for (int m = 0; m < 4; ++m) { asm volatile("" ::: "memory");
                const int kr = u.pm * 256 + ai * 128 + wr * 64 + m * 16 + fq * 4;
                f32x4 r4 = {1.f, 1.f, 1.f, 1.f}; if (!ctx) { r4 = *(const f32x4*)(rskv + kr); r4[0] = __builtin_amdgcn_rsqf(r4[0] * (1.f / 256.f) + EPS); r4[1] = __builtin_amdgcn_rsqf(r4[1] * (1.f / 256.f) + EPS); r4[2] = __builtin_amdgcn_rsqf(r4[2] * (1.f / 256.f) + EPS); r4[3] = __builtin_amdgcn_rsqf(r4[3] * (1.f / 256.f) + EPS); }
                const float r0 = r4[0], r1 = r4[1], r2 = r4[2], r3 = r4[3];
                bf16_t* base; int nk, key;
                if (u.pm < 32) { base = (bf16_t*)((unsigned char*)out + DO_VTP) + (size_t)u.pm * 8 * 64 * 256; nk = 256; key = kr & 255; }
                else { const int b = (u.pm - 32) / 18; base = (bf16_t*)((unsigned char*)out + DO_VTS) + (size_t)b * 8 * 64 * NKS; nk = NKS; key = kr - TP - b * NKS; }
#pragma unroll
                for (int bj = 0; bj < 2; ++bj)
#pragma unroll
                    for (int n = 0; n < 2; ++n) { const int col = u.pn * 256 + bj * 128 + wc * 32 + n * 16 + fr; const f32x4 v = acc[ai][bj][m][n];
                        u32x2 w; w.x = cvtpk(v[0] * r0, v[1] * r1); w.y = cvtpk(v[2] * r2, v[3] * r3);
                        *(u32x2*)(base + (size_t)col * nk + key) = w; }
            }
    }
};
struct EpiGate {
    static constexpr bool PERM = true, SWAP = false;
    unsigned char* ws;
    __device__ __forceinline__ void operator()(f32x4 (&acc)[2][2][4][2], const Unit& u, int wr, int wc, int fr, int fq) const {
        bf16_t* G = (bf16_t*)(ws + WS_G);
#pragma unroll
        for (int ai = 0; ai < 2; ++ai)
#pragma unroll
            for (int m = 0; m < 4; ++m) { asm volatile("" ::: "memory"); const int row = u.pm * 256 + ai * 128 + wr * 64 + m * 16 + fr;
#pragma unroll
                for (int bj = 0; bj < 2; ++bj) { f32x4 v0 = acc[ai][bj][m][0], v1 = acc[ai][bj][m][1]; const int col = u.pn * 256 + bj * 128 + wc * 32 + fq * 8;
#pragma unroll
                    for (int j = 0; j < 4; ++j) { v0[j] = sigm(v0[j]); v1[j] = sigm(v1[j]); }
                    st8(G + (size_t)row * 2048 + col, v0, v1); } }
    }
};
struct EpiMerge {
    static constexpr bool PERM = true, SWAP = false;
    unsigned char* ws;
    __device__ __forceinline__ void operator()(f32x4 (&acc)[2][2][4][2], const Unit& u, int wr, int wc, int fr, int fq) const {
        const bf16_t* G = (const bf16_t*)(ws + WS_G); bf16_t* MG = (bf16_t*)(ws + WS_MERGED);
#pragma unroll
        for (int ai = 0; ai < 2; ++ai)
#pragma unroll
            for (int m = 0; m < 4; ++m) { asm volatile("" ::: "memory"); const int row = u.pm * 256 + ai * 128 + wr * 64 + m * 16 + fr;
#pragma unroll
                for (int bj = 0; bj < 2; ++bj) { const int col = u.pn * 256 + bj * 128 + wc * 32 + fq * 8;
                    const u32x4 gb = *(const u32x4*)(G + (size_t)row * 2048 + 1024 + col);
                    f32x4 b0 = {bflo(gb.x), bfhi(gb.x), bflo(gb.y), bfhi(gb.y)}, b1 = {bflo(gb.z), bfhi(gb.z), bflo(gb.w), bfhi(gb.w)};
                    if (u.flags & 1) { const u32x4 ga = *(const u32x4*)(G + (size_t)row * 2048 + col);
                        f32x4 a0 = {bflo(ga.x), bfhi(ga.x), bflo(ga.y), bfhi(ga.y)}, a1 = {bflo(ga.z), bfhi(ga.z), bflo(ga.w), bfhi(ga.w)};
#pragma unroll
                        for (int j = 0; j < 4; ++j) { acc[ai][bj][m][0][j] *= a0[j] * __builtin_amdgcn_rcpf(fmaxf(b0[j], 1e-30f)); acc[ai][bj][m][1][j] *= a1[j] * __builtin_amdgcn_rcpf(fmaxf(b1[j], 1e-30f)); }
                    } else st8(MG + (size_t)row * 1024 + col, acc[ai][bj][m][0] * b0, acc[ai][bj][m][1] * b1); } }
    }
};
struct EpiRes {
    static constexpr bool PERM = true, SWAP = false;
    const float* xp; const float* xs; float* out; const float* gate;
    __device__ __forceinline__ void operator()(f32x4 (&acc)[2][2][4][2], const Unit& u, int wr, int wc, int fr, int fq) const {
#pragma unroll
        for (int ai = 0; ai < 2; ++ai)
#pragma unroll
            for (int m = 0; m < 4; ++m) { asm volatile("" ::: "memory"); const int row = u.pm * 256 + ai * 128 + wr * 64 + m * 16 + fr;
                const float* g = gate + (size_t)cond_of(row) * 6144;
                const float* bp = xp ? (row < TP ? xp + (size_t)row * 1024 : xs + (size_t)(row - TP) * 1024) : out + (size_t)row * 1024;
                float* op = out + (size_t)row * 1024;
#pragma unroll
                for (int bj = 0; bj < 2; ++bj) { const int col = u.pn * 256 + bj * 128 + wc * 32 + fq * 8;
                    const f32x4 g0 = *(const f32x4*)(g + col), g1 = *(const f32x4*)(g + col + 4), x0 = *(const f32x4*)(bp + col), x1 = *(const f32x4*)(bp + col + 4);
                    *(f32x4*)(op + col) = x0 + g0 * acc[ai][bj][m][0]; *(f32x4*)(op + col + 4) = x1 + g1 * acc[ai][bj][m][1]; } }
    }
};
struct EpiFF1 {
    static constexpr bool PERM = true, SWAP = false;
    unsigned char* ws; int row0;
    __device__ __forceinline__ void operator()(f32x4 (&acc)[2][2][4][2], const Unit& u, int wr, int wc, int fr, int fq) const {
        bf16_t* HID = (bf16_t*)(ws + WS_HID);
#pragma unroll
        for (int ai = 0; ai < 2; ++ai)
#pragma unroll
            for (int m = 0; m < 4; ++m) { asm volatile("" ::: "memory"); const int row = u.pm * 256 + ai * 128 + wr * 64 + m * 16 + fr - row0;
#pragma unroll
                for (int bj = 0; bj < 2; ++bj) { f32x4 v0 = acc[ai][bj][m][0], v1 = acc[ai][bj][m][1]; const int col = u.pn * 256 + bj * 128 + wc * 32 + fq * 8;
#pragma unroll
                    for (int j = 0; j < 4; ++j) { const float a = fmaxf(v0[j], 0.f), b = fmaxf(v1[j], 0.f); v0[j] = a * a; v1[j] = b * b; }
                    st8(HID + (size_t)row * 4096 + col, v0, v1); } }
    }
};

#define MFMA32(a, b, c) __builtin_amdgcn_mfma_f32_32x32x16_bf16((a), (b), (c), 0, 0, 0)
constexpr int AT_KP = 208, AT_VP = 144, AT_KB = 64 * AT_KP, AT_BUF = AT_KB + 64 * AT_VP;
__device__ __forceinline__ void attn_unit(unsigned char* sm, const bf16_t* Qg, const bf16_t* Kn, const bf16_t* KR, const bf16_t* Vt, int NK, int head, bf16_t* Og) {
    int tid_ = threadIdx.x; asm volatile("" : "+v"(tid_));
    const int tid = tid_, lane = tid & 63, wid = tid >> 6, x = lane & 31, hh = lane >> 5;
    const int sig = (x & ~12) | ((x & 4) << 1) | ((x & 8) >> 1);
    bf16x8 qf[6];
    { const bf16_t* qp = Qg + (size_t)(wid * 32 + x) * 768 + head * 96 + hh * 8;
#pragma unroll
      for (int d0 = 0; d0 < 6; ++d0) qf[d0] = *(const bf16x8*)(qp + d0 * 16); }
    const int kkey = tid >> 3, kc = tid & 7, rkey = tid >> 2, rc = tid & 3;
    const bf16_t* kp = Kn + (size_t)kkey * 512 + head * 64 + kc * 8;
    const bf16_t* rp = KR + (size_t)rkey * 32 + rc * 8;
    const bf16_t* vp = Vt + (size_t)kkey * NK + kc * 8;
    const int kdst = kkey * AT_KP + kc * 16, rdst = rkey * AT_KP + 128 + rc * 16, vdst = AT_KB + kkey * AT_VP + kc * 16;
    u32x4 gk, gr, gv;
    gk = *(const u32x4*)kp; gv = *(const u32x4*)vp; if (tid < 256) gr = *(const u32x4*)rp;
    *(u32x4*)(sm + kdst) = gk; *(u32x4*)(sm + vdst) = gv; if (tid < 256) *(u32x4*)(sm + rdst) = gr;
    __syncthreads();
    f32x16 o0 = {}, o1 = {};
    float mrun = -INFINITY, lrun = 0.f;
    const int NT = NK >> 6;
    for (int t = 0; t < NT; ++t) {
        unsigned char* cb = sm + (t & 1) * AT_BUF; unsigned char* nb = sm + ((t + 1) & 1) * AT_BUF;
        const bool more = t + 1 < NT;
        if (more) { const size_t k1 = (size_t)(t + 1) * 64; gk = *(const u32x4*)(kp + k1 * 512); gv = *(const u32x4*)(vp + k1); if (tid < 256) gr = *(const u32x4*)(rp + k1 * 32); }
        f32x16 s0 = {}, s1 = {};
        const unsigned char* ka = cb + sig * AT_KP + hh * 16;
#pragma unroll
        for (int d0 = 0; d0 < 6; ++d0) { const bf16x8 a0 = *(const bf16x8*)(ka + d0 * 32), a1 = *(const bf16x8*)(ka + 32 * AT_KP + d0 * 32);
            s0 = MFMA32(a0, qf[d0], s0); s1 = MFMA32(a1, qf[d0], s1); }
        float mx = fmaxf(s0[0], s1[0]);
#pragma unroll
        for (int i = 1; i < 16; ++i) mx = fmaxf(mx, fmaxf(s0[i], s1[i]));
        mx = fmaxf(mx, __shfl_xor(mx, 32));
        const float mn = fmaxf(mrun, mx); const float alpha = __builtin_amdgcn_exp2f(mrun - mn); mrun = mn;
        float rs = 0.f;
#pragma unroll
        for (int i = 0; i < 16; ++i) { s0[i] = __builtin_amdgcn_exp2f(s0[i] - mn); s1[i] = __builtin_amdgcn_exp2f(s1[i] - mn); rs += s0[i] + s1[i]; }
        lrun = lrun * alpha + rs;
#pragma unroll
        for (int i = 0; i < 16; ++i) { o0[i] *= alpha; o1[i] *= alpha; }
        u32x4 w00, w01, w10, w11;
        w00.x = cvtpk(s0[0], s0[1]); w00.y = cvtpk(s0[2], s0[3]); w00.z = cvtpk(s0[4], s0[5]); w00.w = cvtpk(s0[6], s0[7]);
        w01.x = cvtpk(s0[8], s0[9]); w01.y = cvtpk(s0[10], s0[11]); w01.z = cvtpk(s0[12], s0[13]); w01.w = cvtpk(s0[14], s0[15]);
        w10.x = cvtpk(s1[0], s1[1]); w10.y = cvtpk(s1[2], s1[3]); w10.z = cvtpk(s1[4], s1[5]); w10.w = cvtpk(s1[6], s1[7]);
        w11.x = cvtpk(s1[8], s1[9]); w11.y = cvtpk(s1[10], s1[11]); w11.z = cvtpk(s1[12], s1[13]); w11.w = cvtpk(s1[14], s1[15]);
        const bf16x8 p00 = __builtin_bit_cast(bf16x8, w00), p01 = __builtin_bit_cast(bf16x8, w01), p10 = __builtin_bit_cast(bf16x8, w10), p11 = __builtin_bit_cast(bf16x8, w11);
        const unsigned char* va = cb + AT_KB + x * AT_VP + hh * 16;
        o0 = MFMA32(*(const bf16x8*)(va), p00, o0); o0 = MFMA32(*(const bf16x8*)(va + 32), p01, o0);
        o0 = MFMA32(*(const bf16x8*)(va + 64), p10, o0); o0 = MFMA32(*(const bf16x8*)(va + 96), p11, o0);
        const unsigned char* vb = va + 32 * AT_VP;
        o1 = MFMA32(*(const bf16x8*)(vb), p00, o1); o1 = MFMA32(*(const bf16x8*)(vb + 32), p01, o1);
        o1 = MFMA32(*(const bf16x8*)(vb + 64), p10, o1); o1 = MFMA32(*(const bf16x8*)(vb + 96), p11, o1);
        if (more) { *(u32x4*)(nb + kdst) = gk; *(u32x4*)(nb + vdst) = gv; if (tid < 256) *(u32x4*)(nb + rdst) = gr; }
        __syncthreads();
    }
    const float ltot = lrun + __shfl_xor(lrun, 32); const float inv = 1.f / ltot;
    bf16_t* op = Og + (size_t)(wid * 32 + x) * 512 + head * 64 + hh * 4;
#pragma unroll
    for (int g = 0; g < 4; ++g) {
        u32x2 w; w.x = cvtpk(o0[4 * g] * inv, o0[4 * g + 1] * inv); w.y = cvtpk(o0[4 * g + 2] * inv, o0[4 * g + 3] * inv); *(u32x2*)(op + 8 * g) = w;
        u32x2 w2; w2.x = cvtpk(o1[4 * g] * inv, o1[4 * g + 1] * inv); w2.y = cvtpk(o1[4 * g + 2] * inv, o1[4 * g + 3] * inv); *(u32x2*)(op + 32 + 8 * g) = w2; }
    __syncthreads();
}

constexpr int HG_OF = 0, HG_PART = 65536, HG_SKK = 98304, HG_SQ = 102400, HG_SV = 106496;
__device__ __forceinline__ void hg_stage(unsigned char* sm, const bf16_t* KK, const bf16_t* HQ, const bf16_t* HI, size_t row0, int head, int tokbase, int dirsign, bool withq) {
    const int tid = threadIdx.x, s = tid >> 5, cp = tid & 31;
    const size_t off = (row0 + (size_t)(tokbase + dirsign * s)) * 512 + head * 64 + cp * 2;
    const unsigned a = *(const unsigned*)(KK + off), c = *(const unsigned*)(HI + off);
    *(f32x2*)(sm + HG_SKK + (s * 64 + cp * 2) * 4) = (f32x2){bflo(a), bfhi(a)};
    *(f32x2*)(sm + HG_SV + (s * 64 + cp * 2) * 4) = (f32x2){bflo(c), bfhi(c)};
    if (withq) { const unsigned b = *(const unsigned*)(HQ + off); *(f32x2*)(sm + HG_SQ + (s * 64 + cp * 2) * 4) = (f32x2){bflo(b), bfhi(b)}; }
}
#define HG_UPD(i, kkv, qv) { S[i] = fmaf(kkv, v - S[i], S[i]); o = fmaf(qv, S[i], o); }
__device__ __forceinline__ void hgrn_passA(unsigned char* sm, unsigned char* ws, int item) {
    int tid_ = threadIdx.x; asm volatile("" : "+v"(tid_));
    const int tid = tid_, lane = tid & 63, w = tid >> 6;
    const int sc = item & 15, dir = (item >> 4) & 1, h = (item >> 5) & 7, b = item >> 8;
    const bf16_t* KK = (const bf16_t*)(ws + (dir ? WS_KKB : WS_KKF)); const bf16_t* HI = (const bf16_t*)(ws + WS_HI);
    const size_t row0 = (size_t)TP + (size_t)b * 4096 + sc * 256;
    float S[8], D[8];
#pragma unroll
    for (int i = 0; i < 8; ++i) { S[i] = 0.f; D[i] = 1.f; }
    for (int bt = 0; bt < 16; ++bt) {
        hg_stage(sm, KK, KK, HI, row0, h, dir ? 255 - 16 * bt : 16 * bt, dir ? -1 : 1, false);
        __syncthreads();
#pragma unroll 4
        for (int s = 0; s < 16; ++s) {
            const f32x4 k0 = *(const f32x4*)(sm + HG_SKK + (s * 64 + w * 8) * 4), k1 = *(const f32x4*)(sm + HG_SKK + (s * 64 + w * 8 + 4) * 4);
            const float v = *(const float*)(sm + HG_SV + (s * 64 + lane) * 4);
#pragma unroll
            for (int i = 0; i < 4; ++i) { S[i] = fmaf(k0[i], v - S[i], S[i]); D[i] *= 1.f - k0[i]; S[4 + i] = fmaf(k1[i], v - S[4 + i], S[4 + i]); D[4 + i] *= 1.f - k1[i]; }
        }
        __syncthreads();
    }
    float* SL = (float*)(ws + WS_SL) + (size_t)item * 4096; float* DD = (float*)(ws + WS_DD) + (size_t)item * 64;
#pragma unroll
    for (int i = 0; i < 8; ++i) { SL[(w * 8 + i) * 64 + lane] = S[i]; if (lane == 0) DD[w * 8 + i] = D[i]; }
}
__device__ __forceinline__ void hgrn_passC(unsigned char* sm, unsigned char* ws, const float* state_in, const float* g_hg, float* out, bool prompt, int b, int h, int sc) {
    int tid_ = threadIdx.x; asm volatile("" : "+v"(tid_));
    const int tid = tid_, lane = tid & 63, w = tid >> 6;
    const bf16_t* HQ = (const bf16_t*)(ws + WS_HQ); const bf16_t* HI = (const bf16_t*)(ws + WS_HI); bf16_t* HG = (bf16_t*)(ws + WS_HG);
    const size_t row0 = prompt ? (size_t)b * 256 : (size_t)TP + (size_t)b * 4096 + sc * 256;
    const float gh = g_hg[h * 64 + lane];
    for (int dir = 0; dir < 2; ++dir) {
        const bf16_t* KK = (const bf16_t*)(ws + (dir ? WS_KKB : WS_KKF));
        float S[8];
        if (prompt) {
#pragma unroll
            for (int i = 0; i < 8; ++i) S[i] = 0.f;
        } else {
            const float* s0 = state_in + ((size_t)(b * 2 + dir) * 8 + h) * 4096;
#pragma unroll
            for (int i = 0; i < 8; ++i) S[i] = s0[(w * 8 + i) * 64 + lane];
            const int ibase = ((b * 8 + h) * 2 + dir) * 16;
            const int n = dir ? 15 - sc : sc;
            for (int j = 0; j < n; ++j) { const int it = ibase + (dir ? 15 - j : j);
                const float* SL = (const float*)(ws + WS_SL) + (size_t)it * 4096; const float* DD = (const float*)(ws + WS_DD) + (size_t)it * 64;
#pragma unroll
                for (int i = 0; i < 8; ++i) S[i] = fmaf(DD[w * 8 + i], S[i], SL[(w * 8 + i) * 64 + lane]); }
        }
        for (int bt = 0; bt < 16; ++bt) {
            const int tokbase = dir ? 255 - 16 * bt : 16 * bt, sgn = dir ? -1 : 1;
            hg_stage(sm, KK, HQ, HI, row0, h, tokbase, sgn, true);
            __syncthreads();
#pragma unroll 4
            for (int s = 0; s < 16; ++s) {
                const f32x4 k0 = *(const f32x4*)(sm + HG_SKK + (s * 64 + w * 8) * 4), k1 = *(const f32x4*)(sm + HG_SKK + (s * 64 + w * 8 + 4) * 4);
                const f32x4 q0 = *(const f32x4*)(sm + HG_SQ + (s * 64 + w * 8) * 4), q1 = *(const f32x4*)(sm + HG_SQ + (s * 64 + w * 8 + 4) * 4);
                const float v = *(const float*)(sm + HG_SV + (s * 64 + lane) * 4);
                float o = 0.f;
                HG_UPD(0, k0[0], q0[0]) HG_UPD(1, k0[1], q0[1]) HG_UPD(2, k0[2], q0[2]) HG_UPD(3, k0[3], q0[3])
                HG_UPD(4, k1[0], q1[0]) HG_UPD(5, k1[1], q1[1]) HG_UPD(6, k1[2], q1[2]) HG_UPD(7, k1[3], q1[3])
                *(float*)(sm + HG_PART + ((w * 16 + s) * 64 + lane) * 4) = o;
            }
            __syncthreads();
#pragma unroll
            for (int r = 0; r < 2; ++r) { const int s = w * 2 + r; const int tok = tokbase + sgn * s;
                float o = 0.f;
#pragma unroll
                for (int ww = 0; ww < 8; ++ww) o += *(const float*)(sm + HG_PART + ((ww * 16 + s) * 64 + lane) * 4);
                float* ofp = (float*)(sm + HG_OF + (tok * 64 + lane) * 4);
                if (dir == 0) *ofp = o;
                else { const float tot = *ofp + o; const float ss = wave_sum(tot * tot);
                    bf16_t* hp = HG + (row0 + tok) * 512 + h * 64 + lane;
                    const float val = tot * __builtin_amdgcn_rsqf(ss * (1.f / 64.f) + EPS) * gh * bf2f(*hp);
                    *hp = (bf16_t)(cvtpk(val, 0.f) & 0xffffu); }
            }
        }
        if (prompt) { float* so = out + OUT_STATE + ((size_t)(b * 2 + dir) * 8 + h) * 4096;
#pragma unroll
            for (int i = 0; i < 8; ++i) so[(w * 8 + i) * 64 + lane] = S[i]; }
        __syncthreads();
    }
}

__device__ __forceinline__ void conv_item(const float* W, int ldw, int srccol, const float* kscale, bf16_t* WT, int K, int n0, int k0, float* scr, int lane) {
#pragma unroll 8
    for (int i = 0; i < 32; ++i) { const int kk = 2 * i + (lane >> 5); float v = 0.f;
        if (srccol >= 0) { v = W[(size_t)(k0 + kk) * ldw + srccol + (lane & 31)]; if (kscale) v *= kscale[k0 + kk]; }
        scr[kk * 33 + (lane & 31)] = v; }
    __builtin_amdgcn_s_waitcnt(0xc07f); asm volatile("" ::: "memory");
    const int c = lane & 7;
#pragma unroll
    for (int j = 0; j < 4; ++j) { const int n = (lane >> 3) + 8 * j; const float* s = scr + (8 * c) * 33 + n;
        u32x4 o; o.x = cvtpk(s[0 * 33], s[1 * 33]); o.y = cvtpk(s[2 * 33], s[3 * 33]); o.z = cvtpk(s[4 * 33], s[5 * 33]); o.w = cvtpk(s[6 * 33], s[7 * 33]);
        *(u32x4*)(WT + (size_t)(n0 + n) * K + k0 + 8 * c) = o; }
    __builtin_amdgcn_s_waitcnt(0xc07f); asm volatile("" ::: "memory");
}
__device__ __forceinline__ void sincos_small(float xx, float& s, float& c) {
    const float n = rintf(xx * 0.636619772367581f);
    float r = fmaf(n, -1.5703125f, xx); r = fmaf(n, -4.837512969970703125e-4f, r); r = fmaf(n, -7.54978995489188e-8f, r);
    const float z = r * r;
    const float sp = r + r * z * (-1.6666654611e-1f + z * (8.3321608736e-3f + z * (-1.9515295891e-4f)));
    const float cp = 1.f - 0.5f * z + z * z * (4.166664568298827e-2f + z * (-1.388731625493765e-3f + z * 2.443315711809948e-5f));
    const int q = ((int)n) & 3;
    s = (q == 0) ? sp : (q == 1) ? cp : (q == 2) ? -sp : -cp;
    c = (q == 0) ? cp : (q == 1) ? -sp : (q == 2) ? -cp : sp;
}
__device__ __forceinline__ void modnorm_row(const float* xrow, const float* g, const float* sc, const float* sh, bf16_t* orow, int lane) {
    const f32x4* xr = (const f32x4*)xrow + lane; f32x4 v[4]; float s = 0.f;
#pragma unroll
    for (int j = 0; j < 4; ++j) { v[j] = xr[64 * j]; s += v[j][0] * v[j][0] + v[j][1] * v[j][1] + v[j][2] * v[j][2] + v[j][3] * v[j][3]; }
    const float r = __builtin_amdgcn_rsqf(wave_sum(s) * (1.f / 1024.f) + EPS);
#pragma unroll
    for (int j = 0; j < 4; ++j) { const int c = (lane + 64 * j) * 4; const f32x4 gg = *(const f32x4*)(g + c), s1 = *(const f32x4*)(sc + c), s2 = *(const f32x4*)(sh + c);
        const f32x4 y = v[j] * r * gg * (1.f + s1) + s2; u32x2 w; w.x = cvtpk(y[0], y[1]); w.y = cvtpk(y[2], y[3]); *(u32x2*)(orow + c) = w; }
}

typedef const __attribute__((address_space(4))) char* kargp_t;
__device__ __forceinline__ const float* inp(int i) {
    kargp_t kp = (kargp_t)__builtin_amdgcn_kernarg_segment_ptr();
    asm volatile("" : "+s"(kp));
    return (const float*)(*(const unsigned long long __attribute__((address_space(4)))*)(kp + i * 8));
}
#define PH_IDS int tid = threadIdx.x; asm volatile("" : "+v"(tid)); const int lane = tid & 63, wave = tid >> 6, gw = c * 8 + wave, NGW = G * 8, gt = c * 512 + tid, NGT = G * 512; (void)lane; (void)wave; (void)gw; (void)NGW; (void)gt; (void)NGT;
__global__ void __launch_bounds__(512, 2) fwd_mega(Ptrs P) {
    extern __shared__ __attribute__((aligned(16))) unsigned char lds[];
    cg::grid_group grid = cg::this_grid();
    const int c = blockIdx.x, G = gridDim.x;
    unsigned char* ws = P.ws; float* out = P.out;
    volatile LAS unsigned* bst = (volatile LAS unsigned*)((LAS unsigned char*)lds + 131072 + 64);
    if (threadIdx.x < 2) bst[threadIdx.x] = 0u;
    if (c == 0) for (int i = threadIdx.x; i < XCD_BAR_WORDS; i += 512) ((unsigned*)(ws + WS_BAR))[i] = 0u;
    LAS unsigned char* lds3 = (LAS unsigned char*)lds;
    float* mods = (float*)(ws + WS_MODS);

#ifndef SKIP_PH0
    {
        PH_IDS
        float* rs = (float*)(ws + WS_RSQ); for (int i = gt; i < 65536; i += NGT) rs[i] = 0.f;
        float* rope = (float*)(ws + WS_ROPE);
        for (int i = gt; i < 4096 * 16; i += NGT) { const int pos = i >> 4, pr = i & 15; const float p = (pr < 8) ? (float)(pos >> 6) : (float)(pos & 63);
            const float ang = p * exp2f(-1.6609640474436813f * (float)(pr & 7)); float s, cc; sincos_small(ang, s, cc); rope[2 * i] = cc; rope[2 * i + 1] = s; }
        { const float* lg = inp(17); float* lb = (float*)(ws + WS_LB); for (int i = gt; i < 1024; i += NGT) lb[i] = 1.f / (1.f + __expf(lg[i] - lg[1024 + i])); }
        { const float* cc = inp(2); const float* gk = inp(14); bf16_t* CK = (bf16_t*)(ws + WS_CKVA);
          for (int i = gt; i < 2048 * 256 / 2; i += NGT) { const int e = i * 2, r = e >> 8, col = e & 255, b = r >> 9, j = r & 511;
              const size_t kr = (size_t)TP + (size_t)b * NKS + 4096 + j; *(unsigned*)(CK + kr * 256 + col) = cvtpk(cc[e] / gk[col], cc[e + 1] / gk[col + 1]); }
          const float* ck = inp(3); bf16_t* KRb = (bf16_t*)((unsigned char*)out + DO_KR);
          for (int i = gt; i < 2048 * 32 / 2; i += NGT) { const int e = i * 2, r = e >> 5, col = e & 31, b = r >> 9, j = r & 511;
              const size_t kr = (size_t)TP + (size_t)b * NKS + 4096 + j; *(unsigned*)(KRb + kr * 32 + col) = cvtpk(ck[e], ck[e + 1]); } }
        if (c < 96) {
            const float* wa = inp(7); const float* ba = inp(8); const float* cv = inp(5); const float* cx = inp(6);
            float a0 = 0.f, a1 = 0.f, a2 = 0.f, a3 = 0.f, a4 = 0.f; const int col = c * 64 + lane;
#pragma unroll 8
            for (int k = wave * 128; k < wave * 128 + 128; ++k) { const float wv = wa[(size_t)k * 6144 + col];
                a0 = fmaf(silu(cv[k]), wv, a0); a1 = fmaf(silu(cv[1024 + k]), wv, a1); a2 = fmaf(silu(cv[2048 + k]), wv, a2); a3 = fmaf(silu(cv[3072 + k]), wv, a3); a4 = fmaf(silu(cx[k]), wv, a4); }
            float* red = (float*)lds + 8 * 2112 + wave * 320;
            red[lane] = a0; red[64 + lane] = a1; red[128 + lane] = a2; red[192 + lane] = a3; red[256 + lane] = a4;
            __syncthreads();
            if (tid < 320) { float s = 0.f; for (int w2 = 0; w2 < 8; ++w2) s += ((float*)lds + 8 * 2112)[w2 * 320 + tid]; const int cd = tid >> 6, l2 = tid & 63; mods[cd * 6144 + c * 64 + l2] = s + ba[c * 64 + l2]; }
            __syncthreads();
        }
        float* scr = (float*)lds + wave * 2112;
        const float* w_in = inp(11);
        constexpr int I0 = 104 * 16, I1 = 64 * 16, I2 = 24 * 6, I3 = 16 * 4, I4 = 16 * 4, I5 = 32 * 8, I6 = 32 * 8, I7 = 32 * 16, I8 = 128 * 16, I9 = 32 * 64;
        constexpr int NIT = I0 + I1 + I2 + I3 + I4 + I5 + I6 + I7 + I8 + I9;
        for (int it = gw; it < NIT; it += NGW) {
            int r = it;
            if (r < I0) { const int nb = r >> 4, kb = r & 15, n = nb * 32; const int src = n < 256 ? 384 + n : n < 640 ? n - 256 : n < 672 ? n : n < 768 ? -1 : n - 96;
                conv_item(w_in, NIN, src, nullptr, (bf16_t*)(ws + WS_WIN), 1024, n, kb * 64, scr, lane); continue; } r -= I0;
            if (r < I1) { const int nb = r >> 4, kb = r & 15; conv_item(w_in, NIN, 3232 + nb * 32, nullptr, (bf16_t*)(ws + WS_WG), 1024, nb * 32, kb * 64, scr, lane); continue; } r -= I1;
            if (r < I2) { const int nb = r / 6, kb = r % 6; conv_item(inp(13), 768, nb * 32, inp(12), (bf16_t*)(ws + WS_WUQ), 384, nb * 32, kb * 64, scr, lane); continue; } r -= I2;
            if (r < I3) { const int nb = r >> 2, kb = r & 3, n = nb * 32; conv_item(inp(15), 1024, (n >> 6) * 128 + (n & 63), inp(14), (bf16_t*)(ws + WS_WUK), 256, n, kb * 64, scr, lane); continue; } r -= I3;
            if (r < I4) { const int nb = r >> 2, kb = r & 3, n = nb * 32; conv_item(inp(15), 1024, (n >> 6) * 128 + 64 + (n & 63), inp(14), (bf16_t*)(ws + WS_WUV), 256, n, kb * 64, scr, lane); continue; } r -= I4;
            if (r < I5) { const int nb = r >> 3, kb = r & 7; conv_item(inp(18), 1024, nb * 32, nullptr, (bf16_t*)(ws + WS_W1), 512, nb * 32, kb * 64, scr, lane); continue; } r -= I5;
            if (r < I6) { const int nb = r >> 3, kb = r & 7; conv_item(inp(19), 1024, nb * 32, nullptr, (bf16_t*)(ws + WS_W2), 512, nb * 32, kb * 64, scr, lane); continue; } r -= I6;
            if (r < I7) { const int nb = r >> 4, kb = r & 15; conv_item(inp(20), 1024, nb * 32, nullptr, (bf16_t*)(ws + WS_WOUT), 1024, nb * 32, kb * 64, scr, lane); continue; } r -= I7;
            if (r < I8) { const int nb = r >> 4, kb = r & 15; conv_item(inp(21), 4096, nb * 32, nullptr, (bf16_t*)(ws + WS_WFF1), 1024, nb * 32, kb * 64, scr, lane); continue; } r -= I8;
            { const int nb = r >> 6, kb = r & 63; conv_item(inp(22), 1024, nb * 32, nullptr, (bf16_t*)(ws + WS_WFF2), 4096, nb * 32, kb * 64, scr, lane); }
        }
    }
#endif
    grid.sync();
    const XcdBarrier xbar = xcd_barrier_post((unsigned*)(ws + WS_BAR), bst);

#ifndef SKIP_PH0B
    { PH_IDS
    for (int r = gw; r < T; r += NGW) { const float* md = mods + (size_t)cond_of(r) * 6144;
        modnorm_row(r < TP ? inp(0) + (size_t)r * 1024 : inp(1) + (size_t)(r - TP) * 1024, inp(9), md + 1024, md, (bf16_t*)(ws + WS_H) + (size_t)r * 1024, lane); } }
#endif
    xcd_barrier(xbar);
#ifndef SKIP_PH1
    { RangeSched S{(const char*)(ws + WS_H), (const char*)(ws + WS_WIN), (size_t)256 * 1024 * 2, (size_t)256 * 1024 * 2, 13, 96 * 13, c, G, 0};
      EpiIn E{ws, out}; pg8::gemm_phase(lds3, 1024, 1024, 1024, S, E); }
#endif
    xcd_barrier(xbar);
#ifndef SKIP_PH2
    { RangeSched SQ{(const char*)(ws + WS_QLAT), (const char*)(ws + WS_WUQ), (size_t)256 * 384 * 2, (size_t)256 * 384 * 2, 3, 288, first_of(0, c, G), G, 0};
      EpiQ EQ{ws, out}; pg8::gemm_phase(lds3, 384, 384, 384, SQ, EQ);
      RangeSched SK{(const char*)(ws + WS_CKVA), (const char*)(ws + WS_WUK), (size_t)256 * 256 * 2, (size_t)256 * 256 * 2, 2, 208, first_of(288, c, G), G, 0};
      EpiK EK{ws, out}; pg8::gemm_phase(lds3, 256, 256, 256, SK, EK);
      RangeSched SV{(const char*)(ws + WS_CKVA), (const char*)(ws + WS_WUV), (size_t)256 * 256 * 2, (size_t)256 * 256 * 2, 2, 208, first_of(496, c, G), G, 0};
      EpiV EV{ws, out}; pg8::gemm_phase(lds3, 256, 256, 256, SV, EV);
      { PH_IDS
 const bf16_t* CK = (const bf16_t*)(ws + WS_CKVA); const float* rskv = (const float*)(ws + WS_RSKV); const float* gk = inp(14);
        for (int i = gt; i < TP * 256 / 4; i += NGT) { const int e = i * 4, r = e >> 8, col = e & 255; const float rr = __builtin_amdgcn_rsqf(rskv[r] * (1.f / 256.f) + EPS);
            const u32x2 w = *(const u32x2*)(CK + e); const f32x4 g4 = *(const f32x4*)(gk + col);
            *(f32x4*)(out + OUT_CKV + e) = (f32x4){bflo(w.x) * rr * g4[0], bfhi(w.x) * rr * g4[1], bflo(w.y) * rr * g4[2], bfhi(w.y) * rr * g4[3]}; } }
      __syncthreads();
      for (int it = c; it < 1024; it += G) hgrn_passA(lds, ws, it);
    }
#endif
    xcd_barrier(xbar);
#ifndef SKIP_PH3
    {
        const bf16_t* Q = (const bf16_t*)((unsigned char*)out + DO_Q); const bf16_t* Kn = (const bf16_t*)((unsigned char*)out + DO_KN); const bf16_t* KRb = (const bf16_t*)((unsigned char*)out + DO_KR);
        bf16_t* OM = (bf16_t*)(ws + WS_OMLA);
        for (int u = c; u < 512; u += G) { const int b = u >> 7, h = (u >> 4) & 7, qb = u & 15; const size_t qrow = (size_t)TP + (size_t)b * 4096 + qb * 256, kr0 = (size_t)TP + (size_t)b * NKS;
            attn_unit(lds, Q + qrow * 768, Kn + kr0 * 512, KRb + kr0 * 32, (const bf16_t*)((unsigned char*)out + DO_VTS) + ((size_t)(b * 8 + h) * 64) * NKS, NKS, h, OM + qrow * 512); }
        for (int u = c; u < 256; u += G) { const int b = u >> 3, h = u & 7; const size_t qrow = (size_t)b * 256;
            attn_unit(lds, Q + qrow * 768, Kn + qrow * 512, KRb + qrow * 32, (const bf16_t*)((unsigned char*)out + DO_VTP) + ((size_t)(b * 8 + h) * 64) * 256, 256, h, OM + qrow * 512); }
        for (int u = c; u < 512; u += G) hgrn_passC(lds, ws, inp(4), inp(16), out, false, u >> 7, (u >> 4) & 7, u & 15);
        for (int u = c; u < 256; u += G) hgrn_passC(lds, ws, inp(4), inp(16), out, true, u >> 3, u & 7, 0);
    }
#endif
    xcd_barrier(xbar);
#ifndef SKIP_PH4A
    { RangeSched S{(const char*)(ws + WS_H), (const char*)(ws + WS_WG), (size_t)256 * 1024 * 2, (size_t)256 * 1024 * 2, 8, 768, c, G, 0};
      EpiGate E{ws}; pg8::gemm_phase(lds3, 1024, 1024, 1024, S, E); }
#endif
    xcd_barrier(xbar);
#ifndef SKIP_PH4B
    { MergeSched S{(const char*)(ws + WS_OMLA), (const char*)(ws + WS_HG), (const char*)(ws + WS_W1), (const char*)(ws + WS_W2), (size_t)256 * 512 * 2, (size_t)256 * 512 * 2, 384, c, G};
      EpiMerge E{ws}; pg8::gemm_phase(lds3, 512, 512, 512, S, E); }
#endif
    xcd_barrier(xbar);
#ifndef SKIP_PH5
    { RangeSched S{(const char*)(ws + WS_MERGED), (const char*)(ws + WS_WOUT), (size_t)256 * 1024 * 2, (size_t)256 * 1024 * 2, 4, 384, c, G, 0};
      EpiRes E{inp(0), inp(1), out, mods + 2 * 1024}; pg8::gemm_phase(lds3, 1024, 1024, 1024, S, E); }
#endif
    xcd_barrier(xbar);
#ifndef SKIP_PH5B
    { PH_IDS
    for (int r = gw; r < T; r += NGW) { const float* md = mods + (size_t)cond_of(r) * 6144;
        modnorm_row(out + (size_t)r * 1024, inp(10), md + 4 * 1024, md + 3 * 1024, (bf16_t*)(ws + WS_H2) + (size_t)r * 1024, lane); } }
#endif
    xcd_barrier(xbar);
#ifndef SKIP_PH67
#pragma unroll
    for (int hf = 0; hf < 2; ++hf) {
        { RangeSched S{(const char*)(ws + WS_H2) + (size_t)hf * 12288 * 1024 * 2, (const char*)(ws + WS_WFF1), (size_t)256 * 1024 * 2, (size_t)256 * 1024 * 2, 16, 768, c, G, hf * 48};
          EpiFF1 E{ws, hf * 12288}; pg8::gemm_phase(lds3, 1024, 1024, 1024, S, E); }
        xcd_barrier(xbar);
        { RangeSched S{(const char*)(ws + WS_HID), (const char*)(ws + WS_WFF2), (size_t)256 * 4096 * 2, (size_t)256 * 4096 * 2, 4, 192, c, G, hf * 48};
          EpiRes E{nullptr, nullptr, out, mods + 5 * 1024}; pg8::gemm_phase(lds3, 4096, 4096, 4096, S, E); }
        xcd_barrier(xbar);
    }
#endif
#ifndef SKIP_PH8
    { PH_IDS
      const float* gf = inp(23);
      for (int r = gw; r < T; r += NGW) { f32x4* xr = (f32x4*)(out + (size_t)r * 1024) + lane; f32x4 v[4]; float s = 0.f;
#pragma unroll
          for (int j = 0; j < 4; ++j) { v[j] = xr[64 * j]; s += v[j][0] * v[j][0] + v[j][1] * v[j][1] + v[j][2] * v[j][2] + v[j][3] * v[j][3]; }
          const float rr = __builtin_amdgcn_rsqf(wave_sum(s) * (1.f / 1024.f) + EPS);
#pragma unroll
          for (int j = 0; j < 4; ++j) xr[64 * j] = v[j] * rr * *(const f32x4*)(gf + (lane + 64 * j) * 4); } }
#endif
}

extern "C" void kernel_launch(void* const* d_in, const int* in_sizes, int n_in, void* d_out, int out_size, void* d_ws, size_t ws_size, hipStream_t stream) {
    static int grid = 0;
    if (grid == 0) {
        int dev = 0, cus = 0, per_cu = 0;
        hipGetDevice(&dev); hipDeviceGetAttribute(&cus, hipDeviceAttributeMultiprocessorCount, dev);
        hipFuncSetAttribute((const void*)fwd_mega, hipFuncAttributeMaxDynamicSharedMemorySize, LDS_BYTES);
        hipOccupancyMaxActiveBlocksPerMultiprocessor(&per_cu, (const void*)fwd_mega, 512, LDS_BYTES);
        if (per_cu < 1) { fprintf(stderr, "kernel_launch: occupancy query says %d blocks per CU\n", per_cu); per_cu = 1; }
        grid = cus;
        if (grid > 256) grid = 256;
        (void)hipGetLastError();
    }
    Ptrs p{};
    for (int i = 0; i < 24; ++i) p.in[i] = (const float*)d_in[i];
    p.out = (float*)d_out; p.ws = (unsigned char*)d_ws;
    void* args[] = {&p};
    hipError_t e = hipLaunchCooperativeKernel((const void*)fwd_mega, dim3(grid), dim3(512), args, LDS_BYTES, stream);
    if (e != hipSuccess) fprintf(stderr, "cooperative launch failed: %s (grid %d)\n", hipGetErrorString(e), grid);
}
```

```cpp
#include <hip/hip_runtime.h>
#include <hip/hip_cooperative_groups.h>
#include <cstdint>
#include <cstdio>
namespace cg = cooperative_groups;

#define LAS __attribute__((address_space(3)))
typedef unsigned short bf16_t;
typedef short bf16x8 __attribute__((ext_vector_type(8)));
typedef float f32x4 __attribute__((ext_vector_type(4)));
typedef float f32x2 __attribute__((ext_vector_type(2)));
typedef float f32x16 __attribute__((ext_vector_type(16)));
typedef unsigned u32x4 __attribute__((ext_vector_type(4)));
typedef unsigned u32x2 __attribute__((ext_vector_type(2)));
typedef __bf16 bf16x2_t __attribute__((ext_vector_type(2)));

constexpr int DM = 1024, TP = 8192, TSM = 16384, T = 24576, KRN = 26624, NKS = 4608, NIN = 5280;
constexpr float EPS = 1e-6f;
constexpr float QSCALE = 0.10206207261596575f * 1.4426950408889634f;
constexpr size_t MiB = 1u << 20;
constexpr size_t WS_RSQ = 0, WS_RSKV = 128 * 1024, WS_MODS = 256 * 1024, WS_LB = 384 * 1024, WS_ROPE = 512 * 1024;
constexpr size_t WS_BAR = 1 * MiB;
constexpr size_t WS_WIN = 2 * MiB, WS_WG = WS_WIN + (size_t)3328 * 1024 * 2, WS_WUQ = WS_WG + 4 * MiB, WS_WUK = 13 * MiB + 256 * 1024, WS_WUV = 13 * MiB + 512 * 1024;
constexpr size_t WS_W1 = 14 * MiB, WS_W2 = 15 * MiB, WS_WOUT = 16 * MiB, WS_WFF1 = 18 * MiB, WS_WFF2 = 26 * MiB;
constexpr size_t WS_H = 34 * MiB, WS_QLAT = 82 * MiB, WS_CKVA = 100 * MiB, WS_OMLA = 82 * MiB;
constexpr size_t WS_HQ = 113 * MiB, WS_KKF = 137 * MiB, WS_KKB = 161 * MiB, WS_HI = 185 * MiB, WS_HG = 209 * MiB, WS_SL = 233 * MiB, WS_DD = 249 * MiB;
constexpr size_t WS_G = 113 * MiB, WS_MERGED = 34 * MiB, WS_H2 = 82 * MiB, WS_HID = 130 * MiB;
constexpr size_t DO_Q = 0, DO_KN = 36 * MiB, DO_KR = 62 * MiB, DO_VTP = 64 * MiB, DO_VTS = 72 * MiB;
constexpr size_t OUT_CKV = 25165824, OUT_KROPE = 27262976, OUT_STATE = 27525120;
constexpr int LDS_BYTES = 147456;

__device__ __forceinline__ unsigned cvtpk(float lo, float hi) { f32x2 v = {lo, hi}; bf16x2_t b = __builtin_convertvector(v, bf16x2_t); return __builtin_bit_cast(unsigned, b); }
__device__ __forceinline__ float bf2f(unsigned short b) { return __uint_as_float(((unsigned)b) << 16); }
__device__ __forceinline__ float bflo(unsigned w) { return __uint_as_float(w << 16); }
__device__ __forceinline__ float bfhi(unsigned w) { return __uint_as_float(w & 0xffff0000u); }
__device__ __forceinline__ void st8(bf16_t* p, f32x4 a, f32x4 b) { u32x4 w; w.x = cvtpk(a[0], a[1]); w.y = cvtpk(a[2], a[3]); w.z = cvtpk(b[0], b[1]); w.w = cvtpk(b[2], b[3]); *(u32x4*)p = w; }
__device__ __forceinline__ float sigm(float v) { return __builtin_amdgcn_rcpf(1.f + __expf(-v)); }
__device__ __forceinline__ float silu(float v) { return v * sigm(v); }
__device__ __forceinline__ float wave_sum(float v) {
#pragma unroll
    for (int o = 1; o < 64; o <<= 1) v += __shfl_xor(v, o);
    return v;
}


#define XB_TMO      128
#define XB_XCNT(j)  (256  + 64 * (j))
#define XB_XSUB(j)  (1280 + 64 * (j))
#define XB_XGEN(j)  (2304 + 64 * (j))
#define XB_TOP      3328
#define XB_TOPGEN   3392
#define XCD_BAR_WORDS 3456
#define XB_SPIN_CAP (1u << 18)
__device__ __forceinline__ unsigned xb_ld(unsigned* p)              { return __hip_atomic_load(p, __ATOMIC_RELAXED, __HIP_MEMORY_SCOPE_AGENT); }
__device__ __forceinline__ unsigned xb_add(unsigned* p, unsigned v) { return __hip_atomic_fetch_add(p, v, __ATOMIC_RELAXED, __HIP_MEMORY_SCOPE_AGENT); }
__device__ __forceinline__ unsigned xb_xcc_id() { return (unsigned)__builtin_amdgcn_s_getreg((3 << 11) | 20) & 0xFu; }
#define XB_SPIN(cond, bar) do { unsigned _sp = 0; while (cond) { __builtin_amdgcn_s_sleep(1); \
    if ((++_sp & 255u) == 0u) { if (xb_ld(&(bar)[XB_TMO])) break; if (_sp > XB_SPIN_CAP) { atomicAdd(&(bar)[XB_TMO], 1u); break; } } } } while (0)
struct XcdBarrier { unsigned* bar; unsigned x; volatile LAS unsigned* st; };
__device__ __forceinline__ XcdBarrier xcd_barrier_post(unsigned* bar, volatile LAS unsigned* st) {
    XcdBarrier b; b.bar = bar; b.x = xb_xcc_id(); b.st = st;
    if (threadIdx.x == 0) (void)xb_add(&bar[XB_XCNT(b.x)], 1u);
    return b;
}
__device__ __forceinline__ void xcd_barrier_complete(unsigned* bar, unsigned x, unsigned& nloc, unsigned& nx) {
    const unsigned G = gridDim.x * gridDim.y * gridDim.z;
    unsigned sum, cnt, mine, sp = 0u;
    for (;;) {
        sum = 0u; cnt = 0u; mine = 0u;
#pragma unroll
        for (unsigned j = 0; j < 16; ++j) { const unsigned c = xb_ld(&bar[XB_XCNT(j)]); sum += c; cnt += (c > 0u) ? 1u : 0u; mine = (j == x) ? c : mine; }
        if (sum == G) break;
        __builtin_amdgcn_s_sleep(1);
        if ((++sp & 255u) == 0u) { if (xb_ld(&bar[XB_TMO])) break; if (sp > XB_SPIN_CAP) { atomicAdd(&bar[XB_TMO], 1u); break; } }
    }
    nloc = mine > 0u ? mine : 1u; nx = cnt > 0u ? cnt : 1u;
}
__device__ __forceinline__ void xcd_barrier(const XcdBarrier& b) {
    asm volatile("s_waitcnt vmcnt(0)" ::: "memory");
    __syncthreads();
    if (threadIdx.x == 0) {
        unsigned* bar = b.bar;
        __builtin_amdgcn_s_waitcnt(0);
        unsigned nloc = b.st[0], nx = b.st[1];
        if (nloc == 0u) { xcd_barrier_complete(bar, b.x, nloc, nx); b.st[0] = nloc; b.st[1] = nx; }
        const unsigned old = xb_add(&bar[XB_XSUB(b.x)], 1u);
        const unsigned gen = old / nloc;
        if (old + 1u == (gen + 1u) * nloc) {
            __builtin_amdgcn_fence(__ATOMIC_RELEASE, "agent");
            asm volatile("s_waitcnt vmcnt(0)" ::: "memory");
            const unsigned og = xb_add(&bar[XB_TOP], 1u);
            const unsigned tg = og / nx;
            if (og + 1u == (tg + 1u) * nx) xb_add(&bar[XB_TOPGEN], 1u);
            else XB_SPIN(xb_ld(&bar[XB_TOPGEN]) == tg, bar);
            __builtin_amdgcn_fence(__ATOMIC_ACQUIRE, "agent");
            xb_add(&bar[XB_XGEN(b.x)], 1u);
            asm volatile("s_waitcnt vmcnt(0)" ::: "memory");
        } else {
            XB_SPIN(xb_ld(&bar[XB_XGEN(b.x)]) == gen, bar);
            __builtin_amdgcn_fence(__ATOMIC_ACQUIRE, "agent");
            asm volatile("s_waitcnt vmcnt(0)" ::: "memory");
        }
    }
    __syncthreads();
}

namespace pg8 {
constexpr int BM = 256, BK = 64, HALF = 128, HTB = HALF * BK * 2, STAGE_BYTES = 8 * HTB;
__host__ __device__ __forceinline__ int lds_byte(int r, int c) { const int st = (r >> 4) * 2 + (c >> 5), rr = r & 15, cc = c & 31, ob = rr * 64 + cc * 2; return st * 1024 + (ob ^ (((ob >> 9) & 1) << 5)); }
__host__ __device__ __forceinline__ void stage_rc(int b, int& R, int& C) { const int st = b / 1024, sb = b % 1024, swz = sb ^ (((sb >> 9) & 1) << 5); R = (st >> 1) * 16 + swz / 64; C = (st & 1) * 32 + (swz % 64) / 2; }
__host__ __device__ __forceinline__ int perm32(int rho) { const int n = rho >> 4, i = rho & 15; return 8 * (i >> 2) + 4 * n + (i & 3); }
struct Unit { const char* A; const char* B; int pm, pn, flags; };

template <class Epi, class Sched>
__device__ __forceinline__ void gemm_phase(LAS unsigned char* lds, const int lda, const int ldb, const int K, const Sched& S, const Epi& E) {
    int tid_ = threadIdx.x; asm volatile("" : "+v"(tid_));
    const int tid = tid_, wid = __builtin_amdgcn_readfirstlane(tid >> 6), lane = tid & 63, wr = wid >> 2, wc = wid & 3, fr = lane & 15, fq = lane >> 4;
    const int nt = K / BK;
    unsigned voffA[2], voffB[2];
#pragma unroll
    for (int i = 0; i < 2; ++i) { int R, C; stage_rc(tid * 16 + i * 8192, R, C); const int Rb = Epi::PERM ? ((R & ~31) + perm32(R & 31)) : R;
        voffA[i] = (unsigned)(R * lda + C) * 2u; voffB[i] = (unsigned)(Rb * ldb + C) * 2u; }
    const size_t kstep = (size_t)(BK * 2);
    const size_t hstepA = (size_t)HALF * lda * 2, hstepB = (size_t)HALF * ldb * 2;
    const unsigned ldsw = (unsigned)wid * 1024u;
    const int aoff = lds_byte(wr * 64 + fr, fq * 8), boff = lds_byte(wc * 32 + fr, fq * 8);
#define PG8_SA(b, h) (((b) * 2 + (h)) * HTB)
#define PG8_SB(b, h) ((4 + (b) * 2 + (h)) * HTB)
#define PG8_STAGE(bufoff, gbase, voff) do { _Pragma("unroll") for (int _i = 0; _i < 2; ++_i) \
        __builtin_amdgcn_global_load_lds((const unsigned*)((const char*)(gbase) + (voff)[_i]), (LAS unsigned*)(lds + (bufoff) + ldsw + _i * 8192), 16, 0, 0); } while (0)
#define PG8_LDA(dst, b, h) do { _Pragma("unroll") for (int m = 0; m < 4; ++m) _Pragma("unroll") for (int k = 0; k < 2; ++k) dst[m][k] = *(const LAS bf16x8*)(lds + PG8_SA(b, h) + aoff + m * 2048 + k * 1024); } while (0)
#define PG8_LDB(dst, b, h) do { _Pragma("unroll") for (int n = 0; n < 2; ++n) _Pragma("unroll") for (int k = 0; k < 2; ++k) dst[n][k] = *(const LAS bf16x8*)(lds + PG8_SB(b, h) + boff + n * 2048 + k * 1024); } while (0)
#define PG8_MMA(ai, bj, At, Bt) do { __builtin_amdgcn_s_setprio(1); _Pragma("unroll") for (int m = 0; m < 4; ++m) _Pragma("unroll") for (int n = 0; n < 2; ++n) _Pragma("unroll") for (int k = 0; k < 2; ++k) \
        acc[ai][bj][m][n] = Epi::SWAP ? __builtin_amdgcn_mfma_f32_16x16x32_bf16(At[m][k], Bt[n][k], acc[ai][bj][m][n], 0, 0, 0) \
                                      : __builtin_amdgcn_mfma_f32_16x16x32_bf16(Bt[n][k], At[m][k], acc[ai][bj][m][n], 0, 0, 0); __builtin_amdgcn_s_setprio(0); } while (0)
#define PG8_WAIT_V(n) asm volatile("s_waitcnt vmcnt(" #n ")" ::: "memory")
#define PG8_WAIT_L(n) asm volatile("s_waitcnt lgkmcnt(" #n ")" ::: "memory")
#define PG8_BAR __builtin_amdgcn_s_barrier()
#define PG8_SCHED __builtin_amdgcn_sched_barrier(0)
    Unit cur, nxt; int ui = 0;
    if (!S.next(0, cur)) return;
    f32x4 acc[2][2][4][2];
#pragma unroll
    for (int a = 0; a < 2; ++a)
#pragma unroll
        for (int b = 0; b < 2; ++b)
#pragma unroll
            for (int m = 0; m < 4; ++m)
#pragma unroll
                for (int n = 0; n < 2; ++n) acc[a][b][m][n] = (f32x4){0.f, 0.f, 0.f, 0.f};
    bf16x8 At[4][2], B0[2][2], B1[2][2];
    const char* cA = cur.A; const char* cB = cur.B;
    PG8_STAGE(PG8_SB(0, 0), cB, voffB); PG8_STAGE(PG8_SB(0, 1), cB + hstepB, voffB); PG8_STAGE(PG8_SA(0, 0), cA, voffA); PG8_STAGE(PG8_SA(0, 1), cA + hstepA, voffA);
    if (wr == 1) PG8_BAR;
    PG8_WAIT_V(2); PG8_BAR;
    PG8_STAGE(PG8_SB(1, 0), cB + kstep, voffB); PG8_STAGE(PG8_SA(1, 0), cA + kstep, voffA); PG8_STAGE(PG8_SB(1, 1), cB + hstepB + kstep, voffB);
    PG8_WAIT_V(6); PG8_BAR;
    for (;;) {
        const bool has_next = S.next(ui + 1, nxt);
        const char* nA = has_next ? nxt.A : cA; const char* nB = has_next ? nxt.B : cB;
#pragma unroll 1
        for (int t = 0; t < nt; t += 2) {
            const bool last = (t == nt - 2);
            const char* a1 = cA + (size_t)(t + 1) * kstep;
            const char* a2 = last ? nA : cA + (size_t)(t + 2) * kstep; const char* b2 = last ? nB : cB + (size_t)(t + 2) * kstep;
            const char* a3 = a2 + kstep; const char* b3 = b2 + kstep;
            PG8_LDB(B0, 0, 0); PG8_LDB(B1, 0, 1); PG8_SCHED; PG8_LDA(At, 0, 0); PG8_STAGE(PG8_SA(1, 1), a1 + hstepA, voffA);
            PG8_WAIT_V(8); PG8_WAIT_L(0); PG8_BAR; PG8_MMA(0, 0, At, B0); PG8_MMA(0, 1, At, B1); PG8_BAR; PG8_SCHED;
            PG8_LDA(At, 0, 1); PG8_STAGE(PG8_SB(0, 0), b2, voffB); PG8_STAGE(PG8_SB(0, 1), b2 + hstepB, voffB); PG8_STAGE(PG8_SA(0, 0), a2, voffA);
            PG8_WAIT_V(8); PG8_WAIT_L(0); PG8_BAR; PG8_MMA(1, 0, At, B0); PG8_MMA(1, 1, At, B1); PG8_BAR; PG8_SCHED;
            PG8_LDB(B0, 1, 0); PG8_LDB(B1, 1, 1); PG8_SCHED; PG8_LDA(At, 1, 0); PG8_STAGE(PG8_SA(0, 1), a2 + hstepA, voffA);
            PG8_WAIT_V(8); PG8_WAIT_L(0); PG8_BAR; PG8_MMA(0, 0, At, B0); PG8_MMA(0, 1, At, B1); PG8_BAR; PG8_SCHED;
            PG8_LDA(At, 1, 1); PG8_STAGE(PG8_SB(1, 0), b3, voffB); PG8_STAGE(PG8_SB(1, 1), b3 + hstepB, voffB); PG8_STAGE(PG8_SA(1, 0), a3, voffA);
            PG8_WAIT_V(8); PG8_WAIT_L(0); PG8_BAR; PG8_MMA(1, 0, At, B0); PG8_MMA(1, 1, At, B1); PG8_BAR; PG8_SCHED;
        }
        if (wr == 0) PG8_BAR;
        E(acc, cur, wr, wc, fr, fq);
        if (!has_next) break;
        if (!(cur.flags & 1)) {
#pragma unroll
            for (int a = 0; a < 2; ++a)
#pragma unroll
                for (int b = 0; b < 2; ++b)
#pragma unroll
                    for (int m = 0; m < 4; ++m)
#pragma unroll
                        for (int n = 0; n < 2; ++n) acc[a][b][m][n] = (f32x4){0.f, 0.f, 0.f, 0.f};
        }
        cur = nxt; cA = nA; cB = nB; ++ui;
        if (wr == 1) PG8_BAR;
    }
    PG8_WAIT_V(0);
    PG8_BAR;
#undef PG8_SA
#undef PG8_SB
#undef PG8_STAGE
#undef PG8_LDA
#undef PG8_LDB
#undef PG8_MMA
#undef PG8_WAIT_V
#undef PG8_WAIT_L
#undef PG8_BAR
#undef PG8_SCHED
}
}
using pg8::Unit;

struct RangeSched {
    const char* A; const char* B; size_t tA, tB; int nN, n, first, G, pm0;
    __device__ __forceinline__ bool next(int i, Unit& u) const {
        const int idx = first + i * G; if (idx >= n) return false;
        const int pm = idx / nN, pn = idx - pm * nN;
        u.A = A + (size_t)pm * tA; u.B = B + (size_t)pn * tB; u.pm = pm + pm0; u.pn = pn; u.flags = 0; return true; }
};
struct MergeSched {
    const char *A0, *A1, *B0, *B1; size_t tA, tB; int n, c, G;
    __device__ __forceinline__ bool next(int i, Unit& u) const {
        const int tile = c + (i >> 1) * G; if (tile >= n) return false;
        const int seg = i & 1, pm = tile >> 2, pn = tile & 3;
        u.A = (seg ? A1 : A0) + (size_t)pm * tA; u.B = (seg ? B1 : B0) + (size_t)pn * tB; u.pm = pm; u.pn = pn; u.flags = seg ? 0 : 1; return true; }
};
__device__ __forceinline__ int first_of(int base, int c, int G) { return (((c - base) % G) + G) % G; }
__device__ __forceinline__ int key_row(int tok) { if (tok < TP) return tok; const int s = tok - TP; return TP + (s >> 12) * NKS + (s & 4095); }
__device__ __forceinline__ int cond_of(int tok) { return tok < TP ? 4 : ((tok - TP) >> 12); }

struct Ptrs {
    const float* in[24]; float* out; unsigned char* ws;
};

struct EpiIn {
    static constexpr bool PERM = true, SWAP = false;
    unsigned char* ws; float* out;
    __device__ __forceinline__ void operator()(f32x4 (&acc)[2][2][4][2], const Unit& u, int wr, int wc, int fr, int fq) const {
        const int pn = u.pn;
        float* rsq = (float*)(ws + WS_RSQ); float* rskv = (float*)(ws + WS_RSKV);
        const float* rope = (const float*)(ws + WS_ROPE); const float* lb1m = (const float*)(ws + WS_LB);
#pragma unroll
        for (int ai = 0; ai < 2; ++ai)
#pragma unroll
            for (int m = 0; m < 4; ++m) { asm volatile("" ::: "memory");
                const int row = u.pm * 256 + ai * 128 + wr * 64 + m * 16 + fr;
                if (pn == 0) {
                    const int kr = key_row(row); float ss = 0.f;
#pragma unroll
                    for (int bj = 0; bj < 2; ++bj) { const f32x4 v0 = acc[ai][bj][m][0], v1 = acc[ai][bj][m][1]; const int col = bj * 128 + wc * 32 + fq * 8;
                        ss += v0[0] * v0[0] + v0[1] * v0[1] + v0[2] * v0[2] + v0[3] * v0[3] + v1[0] * v1[0] + v1[1] * v1[1] + v1[2] * v1[2] + v1[3] * v1[3];
                        st8((bf16_t*)(ws + WS_CKVA) + (size_t)kr * 256 + col, v0, v1); }
                    ss += __shfl_xor(ss, 16); ss += __shfl_xor(ss, 32);
                    if (fq == 0) atomicAdd(rskv + kr, ss);
                } else if (pn <= 2) {
                    float ss = 0.f;
#pragma unroll
                    for (int bj = 0; bj < 2; ++bj) { const f32x4 v0 = acc[ai][bj][m][0], v1 = acc[ai][bj][m][1]; const int cb = (pn - 1) * 256 + bj * 128 + wc * 32;
                        if (cb < 384) {
                            ss += v0[0] * v0[0] + v0[1] * v0[1] + v0[2] * v0[2] + v0[3] * v0[3] + v1[0] * v1[0] + v1[1] * v1[1] + v1[2] * v1[2] + v1[3] * v1[3];
                            st8((bf16_t*)(ws + WS_QLAT) + (size_t)row * 384 + cb + fq * 8, v0, v1);
                        } else if (cb == 384) {
                            const int j0 = fq * 8; const int kr = key_row(row); bf16_t* krp = (bf16_t*)((unsigned char*)out + DO_KR) + (size_t)kr * 32 + j0;
                            if (row < TP) { float* o = out + OUT_KROPE + (size_t)row * 32 + j0; *(f32x4*)o = v0; *(f32x4*)(o + 4) = v1; st8(krp, v0, v1); }
                            else { const int pos = (row - TP) & 4095; const float* rp = rope + ((size_t)pos * 16 + fq * 4) * 2;
                                const f32x4 cs0 = *(const f32x4*)rp, cs1 = *(const f32x4*)(rp + 4);
                                f32x4 r0, r1;
                                r0[0] = v0[0] * cs0[0] - v0[1] * cs0[1]; r0[1] = v0[0] * cs0[1] + v0[1] * cs0[0];
                                r0[2] = v0[2] * cs0[2] - v0[3] * cs0[3]; r0[3] = v0[2] * cs0[3] + v0[3] * cs0[2];
                                r1[0] = v1[0] * cs1[0] - v1[1] * cs1[1]; r1[1] = v1[0] * cs1[1] + v1[1] * cs1[0];
                                r1[2] = v1[2] * cs1[2] - v1[3] * cs1[3]; r1[3] = v1[2] * cs1[3] + v1[3] * cs1[2];
                                st8(krp, r0, r1); }
                        } }
                    if (pn == 1 || true) { ss += __shfl_xor(ss, 16); ss += __shfl_xor(ss, 32); if (fq == 0 && ss != 0.f) atomicAdd(rsq + row, ss); }
                } else {
                    const int buf = (pn - 3) >> 1; bf16_t* base = (bf16_t*)(ws + WS_HQ + (size_t)buf * 24 * MiB) + (size_t)row * 512;
#pragma unroll
                    for (int bj = 0; bj < 2; ++bj) { f32x4 v0 = acc[ai][bj][m][0], v1 = acc[ai][bj][m][1]; const int col = ((pn - 3) & 1) * 256 + bj * 128 + wc * 32 + fq * 8;
                        if (buf == 0) {
#pragma unroll
                            for (int j = 0; j < 4; ++j) { v0[j] = silu(v0[j]) * 0.125f; v1[j] = silu(v1[j]) * 0.125f; }
                        } else if (buf == 1 || buf == 2) { const float* lp = lb1m + (buf - 1) * 512 + col; const f32x4 l0 = *(const f32x4*)lp, l1 = *(const f32x4*)(lp + 4);
#pragma unroll
                            for (int j = 0; j < 4; ++j) { v0[j] = l0[j] * sigm(-v0[j]); v1[j] = l1[j] * sigm(-v1[j]); }
                        } else if (buf == 4) {
#pragma unroll
                            for (int j = 0; j < 4; ++j) { v0[j] = silu(v0[j]); v1[j] = silu(v1[j]); }
                        }
                        st8(base + col, v0, v1); }
                }
            }
    }
};
struct EpiQ {
    static constexpr bool PERM = true, SWAP = false;
    unsigned char* ws; float* out;
    __device__ __forceinline__ void operator()(f32x4 (&acc)[2][2][4][2], const Unit& u, int wr, int wc, int fr, int fq) const {
        const float* rsq = (const float*)(ws + WS_RSQ); const float* rope = (const float*)(ws + WS_ROPE);
        bf16_t* Q = (bf16_t*)((unsigned char*)out + DO_Q);
#pragma unroll
        for (int ai = 0; ai < 2; ++ai)
#pragma unroll
            for (int m = 0; m < 4; ++m) { asm volatile("" ::: "memory");
                const int row = u.pm * 256 + ai * 128 + wr * 64 + m * 16 + fr;
                const float r = __builtin_amdgcn_rsqf(rsq[row] * (1.f / 384.f) + EPS) * QSCALE;
#pragma unroll
                for (int bj = 0; bj < 2; ++bj) { f32x4 v0 = acc[ai][bj][m][0] * r, v1 = acc[ai][bj][m][1] * r; const int col = u.pn * 256 + bj * 128 + wc * 32 + fq * 8;
                    const int d = col % 96;
                    if (d >= 64 && row >= TP) { const int pos = (row - TP) & 4095; const float* rp = rope + ((size_t)pos * 16 + ((d - 64) >> 1)) * 2;
                        const f32x4 cs0 = *(const f32x4*)rp, cs1 = *(const f32x4*)(rp + 4); f32x4 r0, r1;
                        r0[0] = v0[0] * cs0[0] - v0[1] * cs0[1]; r0[1] = v0[0] * cs0[1] + v0[1] * cs0[0];
                        r0[2] = v0[2] * cs0[2] - v0[3] * cs0[3]; r0[3] = v0[2] * cs0[3] + v0[3] * cs0[2];
                        r1[0] = v1[0] * cs1[0] - v1[1] * cs1[1]; r1[1] = v1[0] * cs1[1] + v1[1] * cs1[0];
                        r1[2] = v1[2] * cs1[2] - v1[3] * cs1[3]; r1[3] = v1[2] * cs1[3] + v1[3] * cs1[2];
                        v0 = r0; v1 = r1; }
                    st8(Q + (size_t)row * 768 + col, v0, v1); }
            }
    }
};
__device__ __forceinline__ bool ctx_tile(int pm) { return pm >= 32 && ((pm - 32) % 18) >= 16; }
__device__ __forceinline__ float rkv_of(const float* rskv, int kr, bool ctx) { return ctx ? 1.f : __builtin_amdgcn_rsqf(rskv[kr] * (1.f / 256.f) + EPS); }
struct EpiK {
    static constexpr bool PERM = true, SWAP = false;
    unsigned char* ws; float* out;
    __device__ __forceinline__ void operator()(f32x4 (&acc)[2][2][4][2], const Unit& u, int wr, int wc, int fr, int fq) const {
        const float* rskv = (const float*)(ws + WS_RSKV); bf16_t* Kn = (bf16_t*)((unsigned char*)out + DO_KN); const bool ctx = ctx_tile(u.pm);
#pragma unroll
        for (int ai = 0; ai < 2; ++ai)
#pragma unroll
            for (int m = 0; m < 4; ++m) { asm volatile("" ::: "memory");
                const int row = u.pm * 256 + ai * 128 + wr * 64 + m * 16 + fr; const float r = rkv_of(rskv, row, ctx);
#pragma unroll
                for (int bj = 0; bj < 2; ++bj) { const int col = u.pn * 256 + bj * 128 + wc * 32 + fq * 8; st8(Kn + (size_t)row * 512 + col, acc[ai][bj][m][0] * r, acc[ai][bj][m][1] * r); }
            }
    }
};
struct EpiV {
    static constexpr bool PERM = false, SWAP = true;
    unsigned char* ws; float* out;
    __device__ __forceinline__ void operator()(f32x4 (&acc)[2][2][4][2], const Unit& u, int wr, int wc, int fr, int fq) const {
        const float* rskv = (const float*)(ws + WS_RSKV); const bool ctx = ctx_tile(u.pm);
#pragma unroll
        for (int ai = 0; ai < 2; ++ai)
#pragma unroll
            for (int m = 0; m < 4; ++m) { asm volatile("" ::: "memory");
                const int kr = u.pm * 256 + ai * 128 + wr * 64 + m * 16 + fq * 4;
                f32x4 r4 = {1.f, 1.f, 1.f, 1.f}; if (!ctx) { r4 = *(const f32x4*)(rskv + kr); r4[0] = __builtin_amdgcn_rsqf(r4[0] * (1.f / 256.f) + EPS); r4[1] = __builtin_amdgcn_rsqf(r4[1] * (1.f / 256.f) + EPS); r4[2] = __builtin_amdgcn_rsqf(r4[2] * (1.f / 256.f) + EPS); r4[3] = __builtin_amdgcn_rsqf(r4[3] * (1.f / 256.f) + EPS); }
                const float r0 = r4[0], r1 = r4[1], r2 = r4[2], r3 = r4[3];
                bf16_t* base; int nk, key;
                if (u.pm < 32) { base = (bf16_t*)((unsigned char*)out + DO_VTP) + (size_t)u.pm * 8 * 64 * 256; nk = 256; key = kr & 255; }
                else { const int b = (u.pm - 32) / 18; base = (bf16_t*)((unsigned char*)out + DO_VTS) + (size_t)b * 8 * 64 * NKS; nk = NKS; key = kr - TP - b * NKS; }
#pragma unroll
                for (int bj = 0; bj < 2; ++bj)
#pragma unroll
                    for (int n = 0; n < 2; ++n) { const int col = u.pn * 256 + bj * 128 + wc * 32 + n * 16 + fr; const f32x4 v = acc[ai][bj][m][n];
                        u32x2 w; w.x = cvtpk(v[0] * r0, v[1] * r1); w.y = cvtpk(v[2] * r2, v[3] * r3);
                        *(u32x2*)(base + (size_t)col * nk + key) = w; }
            }
    }
};
struct EpiGate {
    static constexpr bool PERM = true, SWAP = false;
    unsigned char* ws;
    __device__ __forceinline__ void operator()(f32x4 (&acc)[2][2][4][2], const Unit& u, int wr, int wc, int fr, int fq) const {
        bf16_t* G = (bf16_t*)(ws + WS_G);
#pragma unroll
        for (int ai = 0; ai < 2; ++ai)
#pragma unroll
            for (int m = 0; m < 4; ++m) { asm volatile("" ::: "memory"); const int row = u.pm * 256 + ai * 128 + wr * 64 + m * 16 + fr;
#pragma unroll
                for (int bj = 0; bj < 2; ++bj) { f32x4 v0 = acc[ai][bj][m][0], v1 = acc[ai][bj][m][1]; const int col = u.pn * 256 + bj * 128 + wc * 32 + fq * 8;
#pragma unroll
                    for (int j = 0; j < 4; ++j) { v0[j] = sigm(v0[j]); v1[j] = sigm(v1[j]); }
                    st8(G + (size_t)row * 2048 + col, v0, v1); } }
    }
};
struct EpiMerge {
    static constexpr bool PERM = true, SWAP = false;
    unsigned char* ws;
    __device__ __forceinline__ void operator()(f32x4 (&acc)[2][2][4][2], const Unit& u, int wr, int wc, int fr, int fq) const {
        const bf16_t* G = (const bf16_t*)(ws + WS_G); bf16_t* MG = (bf16_t*)(ws + WS_MERGED);
#pragma unroll
        for (int ai = 0; ai < 2; ++ai)
#pragma unroll
            for (int m = 0; m < 4; ++m) { asm volatile("" ::: "memory"); const int row = u.pm * 256 + ai * 128 + wr * 64 + m * 16 + fr;
#pragma unroll
                for (int bj = 0; bj < 2; ++bj) { const int col = u.pn * 256 + bj * 128 + wc * 32 + fq * 8;
                    const u32x4 gb = *(const u32x4*)(G + (size_t)row * 2048 + 1024 + col);
                    f32x4 b0 = {bflo(gb.x), bfhi(gb.x), bflo(gb.y), bfhi(gb.y)}, b1 = {bflo(gb.z), bfhi(gb.z), bflo(gb.w), bfhi(gb.w)};
                    if (u.flags & 1) { const u32x4 ga = *(const u32x4*)(G + (size_t)row * 2048 + col);
                        f32x4 a0 = {bflo(ga.x), bfhi(ga.x), bflo(ga.y), bfhi(ga.y)}, a1 = {bflo(ga.z), bfhi(ga.z), bflo(ga.w), bfhi(ga.w)};
#pragma unroll
                        for (int j = 0; j < 4; ++j) { acc[ai][bj][m][0][j] *= a0[j] * __builtin_amdgcn_rcpf(fmaxf(b0[j], 1e-30f)); acc[ai][bj][m][1][j] *= a1[j] * __builtin_amdgcn_rcpf(fmaxf(b1[j], 1e-30f)); }
                    } else st8(MG + (size_t)row * 1024 + col, acc[ai][bj][m][0] * b0, acc[ai][bj][m][1] * b1); } }
    }
};
struct EpiRes {
    static constexpr bool PERM = true, SWAP = false;
    const float* xp; const float* xs; float* out; const float* gate;
    __device__ __forceinline__ void operator()(f32x4 (&acc)[2][2][4][2], const Unit& u, int wr, int wc, int fr, int fq) const {
#pragma unroll
        for (int ai = 0; ai < 2; ++ai)
#pragma unroll
            for (int m = 0; m < 4; ++m) { asm volatile("" ::: "memory"); const int row = u.pm * 256 + ai * 128 + wr * 64 + m * 16 + fr;
                const float* g = gate + (size_t)cond_of(row) * 6144;
                const float* bp = xp ? (row < TP ? xp + (size_t)row * 1024 : xs + (size_t)(row - TP) * 1024) : out + (size_t)row * 1024;
                float* op = out + (size_t)row * 1024;
#pragma unroll
                for (int bj = 0; bj < 2; ++bj) { const int col = u.pn * 256 + bj * 128 + wc * 32 + fq * 8;
                    const f32x4 g0 = *(const f32x4*)(g + col), g1 = *(const f32x4*)(g + col + 4), x0 = *(const f32x4*)(bp + col), x1 = *(const f32x4*)(bp + col + 4);
                    *(f32x4*)(op + col) = x0 + g0 * acc[ai][bj][m][0]; *(f32x4*)(op + col + 4) = x1 + g1 * acc[ai][bj][m][1]; } }
    }
};
struct EpiFF1 {
    static constexpr bool PERM = true, SWAP = false;
    unsigned char* ws; int row0;
    __device__ __forceinline__ void operator()(f32x4 (&acc)[2][2][4][2], const Unit& u, int wr, int wc, int fr, int fq) const {
        bf16_t* HID = (bf16_t*)(ws + WS_HID);
#pragma unroll
        for (int ai = 0; ai < 2; ++ai)
#pragma unroll
            for (int m = 0; m < 4; ++m) { asm volatile("" ::: "memory"); const int row = u.pm * 256 + ai * 128 + wr * 64 + m * 16 + fr - row0;
#pragma unroll
                for (int bj = 0; bj < 2; ++bj) { f32x4 v0 = acc[ai][bj][m][0], v1 = acc[ai][bj][m][1]; const int col = u.pn * 256 + bj * 128 + wc * 32 + fq * 8;
#pragma unroll
                    for (int j = 0; j < 4; ++j) { const float a = fmaxf(v0[j], 0.f), b = fmaxf(v1[j], 0.f); v0[j] = a * a; v1[j] = b * b; }
                    st8(HID + (size_t)row * 4096 + col, v0, v1); } }
    }
};

#define MFMA32(a, b, c) __builtin_amdgcn_mfma_f32_32x32x16_bf16((a), (b), (c), 0, 0, 0)
constexpr int AT_KP = 208, AT_VP = 144, AT_KB = 64 * AT_KP, AT_BUF = AT_KB + 64 * AT_VP;
__device__ __forceinline__ void attn_unit(unsigned char* sm, const bf16_t* Qg, const bf16_t* Kn, const bf16_t* KR, const bf16_t* Vt, int NK, int head, bf16_t* Og) {
    int tid_ = threadIdx.x; asm volatile("" : "+v"(tid_));
    const int tid = tid_, lane = tid & 63, wid = tid >> 6, x = lane & 31, hh = lane >> 5;
    const int sig = (x & ~12) | ((x & 4) << 1) | ((x & 8) >> 1);
    bf16x8 qf[6];
    { const bf16_t* qp = Qg + (size_t)(wid * 32 + x) * 768 + head * 96 + hh * 8;
#pragma unroll
      for (int d0 = 0; d0 < 6; ++d0) qf[d0] = *(const bf16x8*)(qp + d0 * 16); }
    const int kkey = tid >> 3, kc = tid & 7, rkey = tid >> 2, rc = tid & 3;
    const bf16_t* kp = Kn + (size_t)kkey * 512 + head * 64 + kc * 8;
    const bf16_t* rp = KR + (size_t)rkey * 32 + rc * 8;
    const bf16_t* vp = Vt + (size_t)kkey * NK + kc * 8;
    const int kdst = kkey * AT_KP + kc * 16, rdst = rkey * AT_KP + 128 + rc * 16, vdst = AT_KB + kkey * AT_VP + kc * 16;
    u32x4 gk, gr, gv;
    gk = *(const u32x4*)kp; gv = *(const u32x4*)vp; if (tid < 256) gr = *(const u32x4*)rp;
    *(u32x4*)(sm + kdst) = gk; *(u32x4*)(sm + vdst) = gv; if (tid < 256) *(u32x4*)(sm + rdst) = gr;
    __syncthreads();
    f32x16 o0 = {}, o1 = {};
    float mrun = -INFINITY, lrun = 0.f;
    const int NT = NK >> 6;
    for (int t = 0; t < NT; ++t) {
        unsigned char* cb = sm + (t & 1) * AT_BUF; unsigned char* nb = sm + ((t + 1) & 1) * AT_BUF;
        const bool more = t + 1 < NT;
        if (more) { const size_t k1 = (size_t)(t + 1) * 64; gk = *(const u32x4*)(kp + k1 * 512); gv = *(const u32x4*)(vp + k1); if (tid < 256) gr = *(const u32x4*)(rp + k1 * 32); }
        f32x16 s0 = {}, s1 = {};
        const unsigned char* ka = cb + sig * AT_KP + hh * 16;
#pragma unroll
        for (int d0 = 0; d0 < 6; ++d0) { const bf16x8 a0 = *(const bf16x8*)(ka + d0 * 32), a1 = *(const bf16x8*)(ka + 32 * AT_KP + d0 * 32);
            s0 = MFMA32(a0, qf[d0], s0); s1 = MFMA32(a1, qf[d0], s1); }
        float mx = fmaxf(s0[0], s1[0]);
#pragma unroll
        for (int i = 1; i < 16; ++i) mx = fmaxf(mx, fmaxf(s0[i], s1[i]));
        mx = fmaxf(mx, __shfl_xor(mx, 32));
        const float mn = fmaxf(mrun, mx); const float alpha = __builtin_amdgcn_exp2f(mrun - mn); mrun = mn;
        float rs = 0.f;
#pragma unroll
        for (int i = 0; i < 16; ++i) { s0[i] = __builtin_amdgcn_exp2f(s0[i] - mn); s1[i] = __builtin_amdgcn_exp2f(s1[i] - mn); rs += s0[i] + s1[i]; }
        lrun = lrun * alpha + rs;
#pragma unroll
        for (int i = 0; i < 16; ++i) { o0[i] *= alpha; o1[i] *= alpha; }
        u32x4 w00, w01, w10, w11;
        w00.x = cvtpk(s0[0], s0[1]); w00.y = cvtpk(s0[2], s0[3]); w00.z = cvtpk(s0[4], s0[5]); w00.w = cvtpk(s0[6], s0[7]);
        w01.x = cvtpk(s0[8], s0[9]); w01.y = cvtpk(s0[10], s0[11]); w01.z = cvtpk(s0[12], s0[13]); w01.w = cvtpk(s0[14], s0[15]);
        w10.x = cvtpk(s1[0], s1[1]); w10.y = cvtpk(s1[2], s1[3]); w10.z = cvtpk(s1[4], s1[5]); w10.w = cvtpk(s1[6], s1[7]);
        w11.x = cvtpk(s1[8], s1[9]); w11.y = cvtpk(s1[10], s1[11]); w11.z = cvtpk(s1[12], s1[13]); w11.w = cvtpk(s1[14], s1[15]);
        const bf16x8 p00 = __builtin_bit_cast(bf16x8, w00), p01 = __builtin_bit_cast(bf16x8, w01), p10 = __builtin_bit_cast(bf16x8, w10), p11 = __builtin_bit_cast(bf16x8, w11);
        const unsigned char* va = cb + AT_KB + x * AT_VP + hh * 16;
        o0 = MFMA32(*(const bf16x8*)(va), p00, o0); o0 = MFMA32(*(const bf16x8*)(va + 32), p01, o0);
        o0 = MFMA32(*(const bf16x8*)(va + 64), p10, o0); o0 = MFMA32(*(const bf16x8*)(va + 96), p11, o0);
        const unsigned char* vb = va + 32 * AT_VP;
        o1 = MFMA32(*(const bf16x8*)(vb), p00, o1); o1 = MFMA32(*(const bf16x8*)(vb + 32), p01, o1);
        o1 = MFMA32(*(const bf16x8*)(vb + 64), p10, o1); o1 = MFMA32(*(const bf16x8*)(vb + 96), p11, o1);
        if (more) { *(u32x4*)(nb + kdst) = gk; *(u32x4*)(nb + vdst) = gv; if (tid < 256) *(u32x4*)(nb + rdst) = gr; }
        __syncthreads();
    }
    const float ltot = lrun + __shfl_xor(lrun, 32); const float inv = 1.f / ltot;
    bf16_t* op = Og + (size_t)(wid * 32 + x) * 512 + head * 64 + hh * 4;
#pragma unroll
    for (int g = 0; g < 4; ++g) {
        u32x2 w; w.x = cvtpk(o0[4 * g] * inv, o0[4 * g + 1] * inv); w.y = cvtpk(o0[4 * g + 2] * inv, o0[4 * g + 3] * inv); *(u32x2*)(op + 8 * g) = w;
        u32x2 w2; w2.x = cvtpk(o1[4 * g] * inv, o1[4 * g + 1] * inv); w2.y = cvtpk(o1[4 * g + 2] * inv, o1[4 * g + 3] * inv); *(u32x2*)(op + 32 + 8 * g) = w2; }
    __syncthreads();
}

constexpr int HW_QP = 0, HW_KP = 4608, HW_KET = 9216, HW_VT = 14336, HW_DEC = 19456, HW_DEC2 = 19712, HW_BYTES = 19968;
__device__ __forceinline__ int sig5(int k) { return (k & ~12) | ((k & 4) << 1) | ((k & 8) >> 1); }
__device__ __forceinline__ void st_bf16(unsigned char* p, float v) { *(bf16_t*)p = (bf16_t)(cvtpk(v, 0.f) & 0xffffu); }
__device__ __forceinline__ bf16x8 pack8(const f32x16& a, int o) { u32x4 w; w.x = cvtpk(a[o], a[o + 1]); w.y = cvtpk(a[o + 2], a[o + 3]); w.z = cvtpk(a[o + 4], a[o + 5]); w.w = cvtpk(a[o + 6], a[o + 7]); return __builtin_bit_cast(bf16x8, w); }
#define WAVE_LDS_SYNC() asm volatile("s_waitcnt lgkmcnt(0)" ::: "memory")

template <bool FULL, int dir>
__device__ __forceinline__ void hg_chain(unsigned char* wl, const bf16_t* KK, const bf16_t* HQ, const bf16_t* HI, bf16_t* OD, size_t row0, int head, int lane,
                                         const float* s0, const float* SLf, const float* DDf, int nfold, int foldstep, float* so, float* ddo) {
    const int x = lane & 31, hh = lane >> 5, sk2 = sig5(lane) * 2, sx = sig5(x);
    f32x16 S[2][2] = {}; float Dtot = 1.f;
    if (s0) {
#pragma unroll
        for (int kb = 0; kb < 2; ++kb)
#pragma unroll
            for (int vb = 0; vb < 2; ++vb)
#pragma unroll
                for (int r = 0; r < 16; ++r) S[kb][vb][r] = s0[(32 * kb + (r & 3) + 8 * (r >> 2) + 4 * hh) * 64 + 32 * vb + x];
        for (int j = 0; j < nfold; ++j) { const float* SL = SLf + (ptrdiff_t)j * foldstep * 4096; const float* DD = DDf + (ptrdiff_t)j * foldstep * 64;
#pragma unroll
            for (int kb = 0; kb < 2; ++kb)
#pragma unroll
                for (int g = 0; g < 4; ++g) { const f32x4 d4 = *(const f32x4*)(DD + 32 * kb + 8 * g + 4 * hh);
#pragma unroll
                    for (int vb = 0; vb < 2; ++vb)
#pragma unroll
                        for (int q = 0; q < 4; ++q) S[kb][vb][4 * g + q] = fmaf(d4[q], S[kb][vb][4 * g + q], SL[(32 * kb + 8 * g + 4 * hh + q) * 64 + 32 * vb + x]); } }
    }
    const unsigned cbase = (unsigned)(row0 * 512) + (unsigned)head * 64u + (unsigned)lane;
#pragma unroll 1
    for (int c = 0; c < 8; ++c) {
        unsigned kpk[16], vpk[16]; float dec;
#define TOKOFF(p) ((unsigned)(dir ? 255 - (p) : (p)) * 512u)
        if (FULL) {
            float R = 1.f; float Kh[16];
#pragma unroll
            for (int s = 16; s < 32; ++s) { const unsigned off = cbase + TOKOFF(32 * c + s); const float kkv = bf2f(KK[off]), qv = bf2f(HQ[off]); const unsigned vv = HI[off];
                const float f = 1.f - kkv; R *= f; const float Ri = __builtin_amdgcn_rcpf(fmaxf(R, 1e-30f));
                Kh[s - 16] = kkv * Ri; st_bf16(wl + HW_QP + s * 144 + sk2, qv * R); st_bf16(wl + HW_KP + s * 144 + sk2, Kh[s - 16]);
                if (s & 1) vpk[s >> 1] |= vv << 16; else vpk[s >> 1] = vv;
                if ((s & 7) == 7) __builtin_amdgcn_sched_barrier(0); }
#pragma unroll
            for (int j = 0; j < 8; ++j) kpk[8 + j] = cvtpk(Kh[2 * j] * R, Kh[2 * j + 1] * R);
            float M = 1.f, keh = 0.f;
#pragma unroll
            for (int s = 15; s >= 0; --s) { const unsigned off = cbase + TOKOFF(32 * c + s); const float kkv = bf2f(KK[off]), qv = bf2f(HQ[off]); const unsigned vv = HI[off];
                const float f = 1.f - kkv; const float Mi = __builtin_amdgcn_rcpf(fmaxf(M, 1e-30f));
                const float kd = kkv * M; st_bf16(wl + HW_QP + s * 144 + sk2, qv * Mi); st_bf16(wl + HW_KP + s * 144 + sk2, kd);
                if (s & 1) { vpk[s >> 1] = vv << 16; keh = kd * R; } else { vpk[s >> 1] |= vv; kpk[s >> 1] = cvtpk(kd * R, keh); }
                M *= f;
                if ((s & 7) == 0) __builtin_amdgcn_sched_barrier(0); }
            dec = M * R;
            *(float*)(wl + HW_DEC2 + lane * 4) = M;
        } else {
            float Pd = 1.f, keh = 0.f;
#pragma unroll
            for (int s = 31; s >= 0; --s) { const unsigned off = cbase + TOKOFF(32 * c + s); const float kkv = bf2f(KK[off]); const unsigned vv = HI[off];
                const float ke = kkv * Pd; Pd *= 1.f - kkv;
                if (s & 1) { vpk[s >> 1] = vv << 16; keh = ke; } else { vpk[s >> 1] |= vv; kpk[s >> 1] = cvtpk(ke, keh); }
                if ((s & 7) == 0) __builtin_amdgcn_sched_barrier(0); }
            dec = Pd;
        }
        Dtot *= dec;
#pragma unroll
        for (int j = 0; j < 4; ++j) { u32x4 w; w.x = kpk[4 * j]; w.y = kpk[4 * j + 1]; w.z = kpk[4 * j + 2]; w.w = kpk[4 * j + 3]; *(u32x4*)(wl + HW_KET + lane * 80 + j * 16) = w;
            u32x4 wv; wv.x = vpk[4 * j]; wv.y = vpk[4 * j + 1]; wv.z = vpk[4 * j + 2]; wv.w = vpk[4 * j + 3]; *(u32x4*)(wl + HW_VT + lane * 80 + j * 16) = wv; }
        *(float*)(wl + HW_DEC + lane * 4) = dec;
        WAVE_LDS_SYNC();
        const unsigned char* vt0 = wl + HW_VT + x * 80 + hh * 16; const unsigned char* vt1 = vt0 + 32 * 80;
        if (FULL) {
            f32x16 at = {};
            const unsigned char* kp = wl + HW_KP + sx * 144 + hh * 16; const unsigned char* qp = wl + HW_QP + x * 144 + hh * 16;
#pragma unroll
            for (int ks = 0; ks < 4; ++ks) at = MFMA32(*(const bf16x8*)(kp + ks * 32), *(const bf16x8*)(qp + ks * 32), at);
            { int xo = x - 8 * hh; asm volatile("" : "+v"(xo));
#pragma unroll
              for (int r = 0; r < 16; ++r) { const int sv = (r & 3) + 4 * ((r >> 2) & 1) + 16 * (r >> 3); if (sv > xo) at[r] = 0.f; } }
            const bf16x8 pa0 = pack8(at, 0), pa1 = pack8(at, 8);
            const size_t orow = (row0 + (size_t)(dir ? 255 - (32 * c + x) : (32 * c + x))) * 512 + (size_t)head * 64 + hh * 4;
#pragma unroll
            for (int vb = 0; vb < 2; ++vb) { const unsigned char* vt = vb ? vt1 : vt0;
                f32x16 o = {};
                o = MFMA32(*(const bf16x8*)(vt), pa0, o); o = MFMA32(*(const bf16x8*)(vt + 32), pa1, o);
#pragma unroll
                for (int kb = 0; kb < 2; ++kb) { f32x16 sm_;
#pragma unroll
                    for (int g = 0; g < 4; ++g) { const f32x4 m4 = *(const f32x4*)(wl + HW_DEC2 + (32 * kb + 8 * g + 4 * hh) * 4);
#pragma unroll
                        for (int q = 0; q < 4; ++q) sm_[4 * g + q] = S[kb][vb][4 * g + q] * m4[q]; }
                    o = MFMA32(pack8(sm_, 0), *(const bf16x8*)(qp + kb * 64), o); o = MFMA32(pack8(sm_, 8), *(const bf16x8*)(qp + kb * 64 + 32), o); }
#pragma unroll
                for (int g = 0; g < 4; ++g) { u32x2 w; w.x = cvtpk(o[4 * g], o[4 * g + 1]); w.y = cvtpk(o[4 * g + 2], o[4 * g + 3]); *(u32x2*)(OD + orow + vb * 32 + 8 * g) = w; } }
        }
#pragma unroll
        for (int kb = 0; kb < 2; ++kb) { const unsigned char* ke = wl + HW_KET + (32 * kb + x) * 80 + hh * 16; const bf16x8 ke0 = *(const bf16x8*)ke, ke1 = *(const bf16x8*)(ke + 32);
            f32x4 d4[4];
#pragma unroll
            for (int g = 0; g < 4; ++g) d4[g] = *(const f32x4*)(wl + HW_DEC + (32 * kb + 8 * g + 4 * hh) * 4);
#pragma unroll
            for (int vb = 0; vb < 2; ++vb) { const unsigned char* vt = vb ? vt1 : vt0;
#pragma unroll
                for (int r = 0; r < 16; ++r) S[kb][vb][r] *= d4[r >> 2][r & 3];
                S[kb][vb] = MFMA32(ke0, *(const bf16x8*)(vt), S[kb][vb]); S[kb][vb] = MFMA32(ke1, *(const bf16x8*)(vt + 32), S[kb][vb]); } }
        WAVE_LDS_SYNC();
#undef TOKOFF
    }
    if (so) {
#pragma unroll
        for (int kb = 0; kb < 2; ++kb)
#pragma unroll
            for (int vb = 0; vb < 2; ++vb)
#pragma unroll
                for (int r = 0; r < 16; ++r) so[(32 * kb + (r & 3) + 8 * (r >> 2) + 4 * hh) * 64 + 32 * vb + x] = S[kb][vb][r];
    }
    if (ddo) ddo[lane] = Dtot;
}
__device__ __forceinline__ void hgrn_passA(unsigned char* sm, unsigned char* ws, int c, int G) {
    int tid_ = threadIdx.x; asm volatile("" : "+v"(tid_));
    const int lane = tid_ & 63, w = __builtin_amdgcn_readfirstlane(tid_ >> 6), x = lane & 31, hh = lane >> 5;
    for (int id = c + G * w; id < 1024 && w < 4; id += 4 * G) {
        const int sc = id & 15, dir = (id >> 4) & 1, h = (id >> 5) & 7, b = id >> 8;
        const bf16_t* KK = (const bf16_t*)(ws + (dir ? WS_KKB : WS_KKF));
        float* SL = (float*)(ws + WS_SL) + (size_t)id * 4096; float* DD = (float*)(ws + WS_DD) + (size_t)id * 64;
        const size_t row0 = (size_t)TP + (size_t)b * 4096 + sc * 256; const bf16_t* HI = (const bf16_t*)(ws + WS_HI);
        if (dir) hg_chain<false, 1>(sm + w * HW_BYTES, KK, KK, HI, nullptr, row0, h, lane, nullptr, nullptr, nullptr, 0, 0, SL, DD);
        else hg_chain<false, 0>(sm + w * HW_BYTES, KK, KK, HI, nullptr, row0, h, lane, nullptr, nullptr, nullptr, 0, 0, SL, DD);
    }
}
__device__ __forceinline__ void hgrn_passC(unsigned char* sm, unsigned char* ws, const float* state_in, const float* g_hg, float* out, int c, int G) {
    int tid_ = threadIdx.x; asm volatile("" : "+v"(tid_));
    const int tid = tid_, lane = tid & 63, w = __builtin_amdgcn_readfirstlane(tid >> 6), x = lane & 31, hh = lane >> 5;
    {
        const int slot = w >> 1, dir = w & 1, item = c + G * slot;
        if (slot < 3 && item < 768) {
            const bool prompt = item < 256; const int u = item - 256;
            const int b = prompt ? item >> 3 : u >> 7, h = prompt ? item & 7 : (u >> 4) & 7, sc = prompt ? 0 : u & 15;
            const size_t row0 = prompt ? (size_t)b * 256 : (size_t)TP + (size_t)b * 4096 + sc * 256;
            const float* s0 = prompt ? nullptr : state_in + ((size_t)(b * 2 + dir) * 8 + h) * 4096;
            const int ibase = ((b * 8 + h) * 2 + dir) * 16; const int nf = prompt ? 0 : (dir ? 15 - sc : sc); const int it0 = ibase + (dir ? 15 : 0);
            const float* SLf = (const float*)(ws + WS_SL) + (size_t)it0 * 4096; const float* DDf = (const float*)(ws + WS_DD) + (size_t)it0 * 64;
            float* so = prompt ? out + OUT_STATE + ((size_t)(b * 2 + dir) * 8 + h) * 4096 : nullptr;
            bf16_t* KKm = (bf16_t*)(ws + (dir ? WS_KKB : WS_KKF)); const bf16_t* HQ = (const bf16_t*)(ws + WS_HQ); const bf16_t* HI = (const bf16_t*)(ws + WS_HI);
            if (dir) hg_chain<true, 1>(sm + w * HW_BYTES, KKm, HQ, HI, KKm, row0, h, lane, s0, SLf, DDf, nf, -1, so, nullptr);
            else hg_chain<true, 0>(sm + w * HW_BYTES, KKm, HQ, HI, KKm, row0, h, lane, s0, SLf, DDf, nf, 1, so, nullptr);
        }
    }
    asm volatile("s_waitcnt vmcnt(0)" ::: "memory");
    __syncthreads();
    const int tq = tid >> 4, vq = tid & 15;
    for (int slot = 0; slot < 3; ++slot) { const int item = c + G * slot; if (item >= 768) break;
        const bool prompt = item < 256; const int u = item - 256;
        const int b = prompt ? item >> 3 : u >> 7, h = prompt ? item & 7 : (u >> 4) & 7, sc = prompt ? 0 : u & 15;
        const size_t row0 = prompt ? (size_t)b * 256 : (size_t)TP + (size_t)b * 4096 + sc * 256;
        const f32x4 g4 = *(const f32x4*)(g_hg + h * 64 + vq * 4);
        for (int ps = 0; ps < 8; ++ps) { const size_t off = (row0 + ps * 32 + tq) * 512 + (size_t)h * 64 + vq * 4;
            const unsigned long long wf = __hip_atomic_load((const unsigned long long*)((const bf16_t*)(ws + WS_KKF) + off), __ATOMIC_RELAXED, __HIP_MEMORY_SCOPE_AGENT);
            const unsigned long long wb = __hip_atomic_load((const unsigned long long*)((const bf16_t*)(ws + WS_KKB) + off), __ATOMIC_RELAXED, __HIP_MEMORY_SCOPE_AGENT);
            bf16_t* hp = (bf16_t*)(ws + WS_HG) + off; const u32x2 hg = *(const u32x2*)hp;
            const unsigned f0 = (unsigned)wf, f1 = (unsigned)(wf >> 32), b0 = (unsigned)wb, b1 = (unsigned)(wb >> 32);
            const float t0 = bflo(f0) + bflo(b0), t1 = bfhi(f0) + bfhi(b0), t2 = bflo(f1) + bflo(b1), t3 = bfhi(f1) + bfhi(b1);
            float ss = t0 * t0 + t1 * t1 + t2 * t2 + t3 * t3;
            ss += __shfl_xor(ss, 1); ss += __shfl_xor(ss, 2); ss += __shfl_xor(ss, 4); ss += __shfl_xor(ss, 8);
            const float rr = __builtin_amdgcn_rsqf(ss * (1.f / 64.f) + EPS);
            u32x2 o; o.x = cvtpk(t0 * rr * g4[0] * bflo(hg.x), t1 * rr * g4[1] * bfhi(hg.x)); o.y = cvtpk(t2 * rr * g4[2] * bflo(hg.y), t3 * rr * g4[3] * bfhi(hg.y));
            *(u32x2*)hp = o; }
    }
}

__device__ __forceinline__ void conv_item(const float* W, int ldw, int srccol, const float* kscale, bf16_t* WT, int K, int n0, int k0, float* scr, int lane) {
#pragma unroll 8
    for (int i = 0; i < 32; ++i) { const int kk = 2 * i + (lane >> 5); float v = 0.f;
        if (srccol >= 0) { v = W[(size_t)(k0 + kk) * ldw + srccol + (lane & 31)]; if (kscale) v *= kscale[k0 + kk]; }
        scr[kk * 33 + (lane & 31)] = v; }
    __builtin_amdgcn_s_waitcnt(0xc07f); asm volatile("" ::: "memory");
    const int c = lane & 7;
#pragma unroll
    for (int j = 0; j < 4; ++j) { const int n = (lane >> 3) + 8 * j; const float* s = scr + (8 * c) * 33 + n;
        u32x4 o; o.x = cvtpk(s[0 * 33], s[1 * 33]); o.y = cvtpk(s[2 * 33], s[3 * 33]); o.z = cvtpk(s[4 * 33], s[5 * 33]); o.w = cvtpk(s[6 * 33], s[7 * 33]);
        *(u32x4*)(WT + (size_t)(n0 + n) * K + k0 + 8 * c) = o; }
    __builtin_amdgcn_s_waitcnt(0xc07f); asm volatile("" ::: "memory");
}
__device__ __forceinline__ void sincos_small(float xx, float& s, float& c) {
    const float n = rintf(xx * 0.636619772367581f);
    float r = fmaf(n, -1.5703125f, xx); r = fmaf(n, -4.837512969970703125e-4f, r); r = fmaf(n, -7.54978995489188e-8f, r);
    const float z = r * r;
    const float sp = r + r * z * (-1.6666654611e-1f + z * (8.3321608736e-3f + z * (-1.9515295891e-4f)));
    const float cp = 1.f - 0.5f * z + z * z * (4.166664568298827e-2f + z * (-1.388731625493765e-3f + z * 2.443315711809948e-5f));
    const int q = ((int)n) & 3;
    s = (q == 0) ? sp : (q == 1) ? cp : (q == 2) ? -sp : -cp;
    c = (q == 0) ? cp : (q == 1) ? -sp : (q == 2) ? -cp : sp;
}
__device__ __forceinline__ void modnorm_row(const float* xrow, const float* g, const float* sc, const float* sh, bf16_t* orow, int lane) {
    const f32x4* xr = (const f32x4*)xrow + lane; f32x4 v[4]; float s = 0.f;
#pragma unroll
    for (int j = 0; j < 4; ++j) { v[j] = xr[64 * j]; s += v[j][0] * v[j][0] + v[j][1] * v[j][1] + v[j][2] * v[j][2] + v[j][3] * v[j][3]; }
    const float r = __builtin_amdgcn_rsqf(wave_sum(s) * (1.f / 1024.f) + EPS);
#pragma unroll
    for (int j = 0; j < 4; ++j) { const int c = (lane + 64 * j) * 4; const f32x4 gg = *(const f32x4*)(g + c), s1 = *(const f32x4*)(sc + c), s2 = *(const f32x4*)(sh + c);
        const f32x4 y = v[j] * r * gg * (1.f + s1) + s2; u32x2 w; w.x = cvtpk(y[0], y[1]); w.y = cvtpk(y[2], y[3]); *(u32x2*)(orow + c) = w; }
}

typedef const __attribute__((address_space(4))) char* kargp_t;
__device__ __forceinline__ const float* inp(int i) {
    kargp_t kp = (kargp_t)__builtin_amdgcn_kernarg_segment_ptr();
    asm volatile("" : "+s"(kp));
    return (const float*)(*(const unsigned long long __attribute__((address_space(4)))*)(kp + i * 8));
}
#define PH_IDS int tid = threadIdx.x; asm volatile("" : "+v"(tid)); const int lane = tid & 63, wave = tid >> 6, gw = c * 8 + wave, NGW = G * 8, gt = c * 512 + tid, NGT = G * 512; (void)lane; (void)wave; (void)gw; (void)NGW; (void)gt; (void)NGT;
__global__ void __launch_bounds__(512, 2) fwd_mega(Ptrs P) {
    extern __shared__ __attribute__((aligned(16))) unsigned char lds[];
    cg::grid_group grid = cg::this_grid();
    const int c = blockIdx.x, G = gridDim.x;
    unsigned char* ws = P.ws; float* out = P.out;
    volatile LAS unsigned* bst = (volatile LAS unsigned*)((LAS unsigned char*)lds + 131072 + 64);
    if (threadIdx.x < 2) bst[threadIdx.x] = 0u;
    if (c == 0) for (int i = threadIdx.x; i < XCD_BAR_WORDS; i += 512) ((unsigned*)(ws + WS_BAR))[i] = 0u;
    LAS unsigned char* lds3 = (LAS unsigned char*)lds;
    float* mods = (float*)(ws + WS_MODS);

#ifndef SKIP_PH0
    {
        PH_IDS
        float* rs = (float*)(ws + WS_RSQ); for (int i = gt; i < 65536; i += NGT) rs[i] = 0.f;
        float* rope = (float*)(ws + WS_ROPE);
        for (int i = gt; i < 4096 * 16; i += NGT) { const int pos = i >> 4, pr = i & 15; const float p = (pr < 8) ? (float)(pos >> 6) : (float)(pos & 63);
            const float ang = p * exp2f(-1.6609640474436813f * (float)(pr & 7)); float s, cc; sincos_small(ang, s, cc); rope[2 * i] = cc; rope[2 * i + 1] = s; }
        { const float* lg = inp(17); float* lb = (float*)(ws + WS_LB); for (int i = gt; i < 1024; i += NGT) lb[i] = 1.f / (1.f + __expf(lg[i] - lg[1024 + i])); }
        { const float* cc = inp(2); const float* gk = inp(14); bf16_t* CK = (bf16_t*)(ws + WS_CKVA);
          for (int i = gt; i < 2048 * 256 / 2; i += NGT) { const int e = i * 2, r = e >> 8, col = e & 255, b = r >> 9, j = r & 511;
              const size_t kr = (size_t)TP + (size_t)b * NKS + 4096 + j; *(unsigned*)(CK + kr * 256 + col) = cvtpk(cc[e] / gk[col], cc[e + 1] / gk[col + 1]); }
          const float* ck = inp(3); bf16_t* KRb = (bf16_t*)((unsigned char*)out + DO_KR);
          for (int i = gt; i < 2048 * 32 / 2; i += NGT) { const int e = i * 2, r = e >> 5, col = e & 31, b = r >> 9, j = r & 511;
              const size_t kr = (size_t)TP + (size_t)b * NKS + 4096 + j; *(unsigned*)(KRb + kr * 32 + col) = cvtpk(ck[e], ck[e + 1]); } }
        if (c < 96) {
            const float* wa = inp(7); const float* ba = inp(8); const float* cv = inp(5); const float* cx = inp(6);
            float a0 = 0.f, a1 = 0.f, a2 = 0.f, a3 = 0.f, a4 = 0.f; const int col = c * 64 + lane;
#pragma unroll 8
            for (int k = wave * 128; k < wave * 128 + 128; ++k) { const float wv = wa[(size_t)k * 6144 + col];
                a0 = fmaf(silu(cv[k]), wv, a0); a1 = fmaf(silu(cv[1024 + k]), wv, a1); a2 = fmaf(silu(cv[2048 + k]), wv, a2); a3 = fmaf(silu(cv[3072 + k]), wv, a3); a4 = fmaf(silu(cx[k]), wv, a4); }
            float* red = (float*)lds + 8 * 2112 + wave * 320;
            red[lane] = a0; red[64 + lane] = a1; red[128 + lane] = a2; red[192 + lane] = a3; red[256 + lane] = a4;
            __syncthreads();
            if (tid < 320) { float s = 0.f; for (int w2 = 0; w2 < 8; ++w2) s += ((float*)lds + 8 * 2112)[w2 * 320 + tid]; const int cd = tid >> 6, l2 = tid & 63; mods[cd * 6144 + c * 64 + l2] = s + ba[c * 64 + l2]; }
            __syncthreads();
        }
        float* scr = (float*)lds + wave * 2112;
        const float* w_in = inp(11);
        constexpr int I0 = 104 * 16, I1 = 64 * 16, I2 = 24 * 6, I3 = 16 * 4, I4 = 16 * 4, I5 = 32 * 8, I6 = 32 * 8, I7 = 32 * 16, I8 = 128 * 16, I9 = 32 * 64;
        constexpr int NIT = I0 + I1 + I2 + I3 + I4 + I5 + I6 + I7 + I8 + I9;
        for (int it = gw; it < NIT; it += NGW) {
            int r = it;
            if (r < I0) { const int nb = r >> 4, kb = r & 15, n = nb * 32; const int src = n < 256 ? 384 + n : n < 640 ? n - 256 : n < 672 ? n : n < 768 ? -1 : n - 96;
                conv_item(w_in, NIN, src, nullptr, (bf16_t*)(ws + WS_WIN), 1024, n, kb * 64, scr, lane); continue; } r -= I0;
            if (r < I1) { const int nb = r >> 4, kb = r & 15; conv_item(w_in, NIN, 3232 + nb * 32, nullptr, (bf16_t*)(ws + WS_WG), 1024, nb * 32, kb * 64, scr, lane); continue; } r -= I1;
            if (r < I2) { const int nb = r / 6, kb = r % 6; conv_item(inp(13), 768, nb * 32, inp(12), (bf16_t*)(ws + WS_WUQ), 384, nb * 32, kb * 64, scr, lane); continue; } r -= I2;
            if (r < I3) { const int nb = r >> 2, kb = r & 3, n = nb * 32; conv_item(inp(15), 1024, (n >> 6) * 128 + (n & 63), inp(14), (bf16_t*)(ws + WS_WUK), 256, n, kb * 64, scr, lane); continue; } r -= I3;
            if (r < I4) { const int nb = r >> 2, kb = r & 3, n = nb * 32; conv_item(inp(15), 1024, (n >> 6) * 128 + 64 + (n & 63), inp(14), (bf16_t*)(ws + WS_WUV), 256, n, kb * 64, scr, lane); continue; } r -= I4;
            if (r < I5) { const int nb = r >> 3, kb = r & 7; conv_item(inp(18), 1024, nb * 32, nullptr, (bf16_t*)(ws + WS_W1), 512, nb * 32, kb * 64, scr, lane); continue; } r -= I5;
            if (r < I6) { const int nb = r >> 3, kb = r & 7; conv_item(inp(19), 1024, nb * 32, nullptr, (bf16_t*)(ws + WS_W2), 512, nb * 32, kb * 64, scr, lane); continue; } r -= I6;
            if (r < I7) { const int nb = r >> 4, kb = r & 15; conv_item(inp(20), 1024, nb * 32, nullptr, (bf16_t*)(ws + WS_WOUT), 1024, nb * 32, kb * 64, scr, lane); continue; } r -= I7;
            if (r < I8) { const int nb = r >> 4, kb = r & 15; conv_item(inp(21), 4096, nb * 32, nullptr, (bf16_t*)(ws + WS_WFF1), 1024, nb * 32, kb * 64, scr, lane); continue; } r -= I8;
            { const int nb = r >> 6, kb = r & 63; conv_item(inp(22), 1024, nb * 32, nullptr, (bf16_t*)(ws + WS_WFF2), 4096, nb * 32, kb * 64, scr, lane); }
        }
    }
#endif
    grid.sync();
    const XcdBarrier xbar = xcd_barrier_post((unsigned*)(ws + WS_BAR), bst);

#ifndef SKIP_PH0B
    { PH_IDS
    for (int r = gw; r < T; r += NGW) { const float* md = mods + (size_t)cond_of(r) * 6144;
        modnorm_row(r < TP ? inp(0) + (size_t)r * 1024 : inp(1) + (size_t)(r - TP) * 1024, inp(9), md + 1024, md, (bf16_t*)(ws + WS_H) + (size_t)r * 1024, lane); } }
#endif
    xcd_barrier(xbar);
#ifndef SKIP_PH1
    { RangeSched S{(const char*)(ws + WS_H), (const char*)(ws + WS_WIN), (size_t)256 * 1024 * 2, (size_t)256 * 1024 * 2, 13, 96 * 13, c, G, 0};
      EpiIn E{ws, out}; pg8::gemm_phase(lds3, 1024, 1024, 1024, S, E); }
#endif
    xcd_barrier(xbar);
#ifndef SKIP_PH2
    { RangeSched SQ{(const char*)(ws + WS_QLAT), (const char*)(ws + WS_WUQ), (size_t)256 * 384 * 2, (size_t)256 * 384 * 2, 3, 288, first_of(0, c, G), G, 0};
      EpiQ EQ{ws, out}; pg8::gemm_phase(lds3, 384, 384, 384, SQ, EQ);
      RangeSched SK{(const char*)(ws + WS_CKVA), (const char*)(ws + WS_WUK), (size_t)256 * 256 * 2, (size_t)256 * 256 * 2, 2, 208, first_of(288, c, G), G, 0};
      EpiK EK{ws, out}; pg8::gemm_phase(lds3, 256, 256, 256, SK, EK);
      RangeSched SV{(const char*)(ws + WS_CKVA), (const char*)(ws + WS_WUV), (size_t)256 * 256 * 2, (size_t)256 * 256 * 2, 2, 208, first_of(496, c, G), G, 0};
      EpiV EV{ws, out}; pg8::gemm_phase(lds3, 256, 256, 256, SV, EV);
      { PH_IDS
 const bf16_t* CK = (const bf16_t*)(ws + WS_CKVA); const float* rskv = (const float*)(ws + WS_RSKV); const float* gk = inp(14);
        for (int i = gt; i < TP * 256 / 4; i += NGT) { const int e = i * 4, r = e >> 8, col = e & 255; const float rr = __builtin_amdgcn_rsqf(rskv[r] * (1.f / 256.f) + EPS);
            const u32x2 w = *(const u32x2*)(CK + e); const f32x4 g4 = *(const f32x4*)(gk + col);
            *(f32x4*)(out + OUT_CKV + e) = (f32x4){bflo(w.x) * rr * g4[0], bfhi(w.x) * rr * g4[1], bflo(w.y) * rr * g4[2], bfhi(w.y) * rr * g4[3]}; } }
      __syncthreads();
      hgrn_passA(lds, ws, c, G);
    }
#endif
    xcd_barrier(xbar);
#ifndef SKIP_PH3
    {
        const bf16_t* Q = (const bf16_t*)((unsigned char*)out + DO_Q); const bf16_t* Kn = (const bf16_t*)((unsigned char*)out + DO_KN); const bf16_t* KRb = (const bf16_t*)((unsigned char*)out + DO_KR);
        bf16_t* OM = (bf16_t*)(ws + WS_OMLA);
        for (int u = c; u < 512; u += G) { const int b = u >> 7, h = (u >> 4) & 7, qb = u & 15; const size_t qrow = (size_t)TP + (size_t)b * 4096 + qb * 256, kr0 = (size_t)TP + (size_t)b * NKS;
            attn_unit(lds, Q + qrow * 768, Kn + kr0 * 512, KRb + kr0 * 32, (const bf16_t*)((unsigned char*)out + DO_VTS) + ((size_t)(b * 8 + h) * 64) * NKS, NKS, h, OM + qrow * 512); }
        for (int u = c; u < 256; u += G) { const int b = u >> 3, h = u & 7; const size_t qrow = (size_t)b * 256;
            attn_unit(lds, Q + qrow * 768, Kn + qrow * 512, KRb + qrow * 32, (const bf16_t*)((unsigned char*)out + DO_VTP) + ((size_t)(b * 8 + h) * 64) * 256, 256, h, OM + qrow * 512); }
        hgrn_passC(lds, ws, inp(4), inp(16), out, c, G);
    }
#endif
    xcd_barrier(xbar);
#ifndef SKIP_PH4A
    { RangeSched S{(const char*)(ws + WS_H), (const char*)(ws + WS_WG), (size_t)256 * 1024 * 2, (size_t)256 * 1024 * 2, 8, 768, c, G, 0};
      EpiGate E{ws}; pg8::gemm_phase(lds3, 1024, 1024, 1024, S, E); }
#endif
    xcd_barrier(xbar);
#ifndef SKIP_PH4B
    { MergeSched S{(const char*)(ws + WS_OMLA), (const char*)(ws + WS_HG), (const char*)(ws + WS_W1), (const char*)(ws + WS_W2), (size_t)256 * 512 * 2, (size_t)256 * 512 * 2, 384, c, G};
      EpiMerge E{ws}; pg8::gemm_phase(lds3, 512, 512, 512, S, E); }
#endif
    xcd_barrier(xbar);
#ifndef SKIP_PH5
    { RangeSched S{(const char*)(ws + WS_MERGED), (const char*)(ws + WS_WOUT), (size_t)256 * 1024 * 2, (size_t)256 * 1024 * 2, 4, 384, c, G, 0};
      EpiRes E{inp(0), inp(1), out, mods + 2 * 1024}; pg8::gemm_phase(lds3, 1024, 1024, 1024, S, E); }
#endif
    xcd_barrier(xbar);
#ifndef SKIP_PH5B
    { PH_IDS
    for (int r = gw; r < T; r += NGW) { const float* md = mods + (size_t)cond_of(r) * 6144;
        modnorm_row(out + (size_t)r * 1024, inp(10), md + 4 * 1024, md + 3 * 1024, (bf16_t*)(ws + WS_H2) + (size_t)r * 1024, lane); } }
#endif
    xcd_barrier(xbar);
#ifndef SKIP_PH67
#pragma unroll
    for (int hf = 0; hf < 2; ++hf) {
        { RangeSched S{(const char*)(ws + WS_H2) + (size_t)hf * 12288 * 1024 * 2, (const char*)(ws + WS_WFF1), (size_t)256 * 1024 * 2, (size_t)256 * 1024 * 2, 16, 768, c, G, hf * 48};
          EpiFF1 E{ws, hf * 12288}; pg8::gemm_phase(lds3, 1024, 1024, 1024, S, E); }
        xcd_barrier(xbar);
        { RangeSched S{(const char*)(ws + WS_HID), (const char*)(ws + WS_WFF2), (size_t)256 * 4096 * 2, (size_t)256 * 4096 * 2, 4, 192, c, G, hf * 48};
          EpiRes E{nullptr, nullptr, out, mods + 5 * 1024}; pg8::gemm_phase(lds3, 4096, 4096, 4096, S, E); }
        xcd_barrier(xbar);
    }
#endif
#ifndef SKIP_PH8
    { PH_IDS
      const float* gf = inp(23);
      for (int r = gw; r < T; r += NGW) { f32x4* xr = (f32x4*)(out + (size_t)r * 1024) + lane; f32x4 v[4]; float s = 0.f;
#pragma unroll
          for (int j = 0; j < 4; ++j) { v[j] = xr[64 * j]; s += v[j][0] * v[j][0] + v[j][1] * v[j][1] + v[j][2] * v[j][2] + v[j][3] * v[j][3]; }
          const float rr = __builtin_amdgcn_rsqf(wave_sum(s) * (1.f / 1024.f) + EPS);
#pragma unroll
          for (int j = 0; j < 4; ++j) xr[64 * j] = v[j] * rr * *(const f32x4*)(gf + (lane + 64 * j) * 4); } }
#endif
}

extern "C" void kernel_launch(void* const* d_in, const int* in_sizes, int n_in, void* d_out, int out_size, void* d_ws, size_t ws_size, hipStream_t stream) {
    static int grid = 0;
    if (grid == 0) {
        int dev = 0, cus = 0, per_cu = 0;
        hipGetDevice(&dev); hipDeviceGetAttribute(&cus, hipDeviceAttributeMultiprocessorCount, dev);
        hipFuncSetAttribute((const void*)fwd_mega, hipFuncAttributeMaxDynamicSharedMemorySize, LDS_BYTES);
        hipOccupancyMaxActiveBlocksPerMultiprocessor(&per_cu, (const void*)fwd_mega, 512, LDS_BYTES);
        if (per_cu < 1) { fprintf(stderr, "kernel_launch: occupancy query says %d blocks per CU\n", per_cu); per_cu = 1; }
        grid = cus;
        if (grid > 256) grid = 256;
        (void)hipGetLastError();
    }
    Ptrs p{};
    for (int i = 0; i < 24; ++i) p.in[i] = (const float*)d_in[i];
    p.out = (float*)d_out; p.ws = (unsigned char*)d_ws;
    void* args[] = {&p};
    hipError_t e = hipLaunchCooperativeKernel((const void*)fwd_mega, dim3(grid), dim3(512), args, LDS_BYTES, stream);
    if (e != hipSuccess) fprintf(stderr, "cooperative launch failed: %s (grid %d)\n", hipGetErrorString(e), grid);
}
```

```cpp
#include <hip/hip_runtime.h>
#include <hip/hip_cooperative_groups.h>
#include <cstdint>
#include <cstdio>
namespace cg = cooperative_groups;

#define LAS __attribute__((address_space(3)))
typedef unsigned short bf16_t;
typedef short bf16x8 __attribute__((ext_vector_type(8)));
typedef float f32x4 __attribute__((ext_vector_type(4)));
typedef float f32x2 __attribute__((ext_vector_type(2)));
typedef float f32x16 __attribute__((ext_vector_type(16)));
typedef unsigned u32x4 __attribute__((ext_vector_type(4)));
typedef unsigned u32x2 __attribute__((ext_vector_type(2)));
typedef __bf16 bf16x2_t __attribute__((ext_vector_type(2)));

constexpr int DM = 1024, TP = 8192, TSM = 16384, T = 24576, KRN = 26624, NKS = 4608, NIN = 5280;
constexpr float EPS = 1e-6f;
constexpr float QSCALE = 0.10206207261596575f * 1.4426950408889634f;
constexpr size_t MiB = 1u << 20;
constexpr size_t WS_RSQ = 0, WS_RSKV = 128 * 1024, WS_MODS = 256 * 1024, WS_LB = 384 * 1024, WS_ROPE = 512 * 1024;
constexpr size_t WS_BAR = 1 * MiB, WS_RS2 = 1 * MiB + 32 * 1024, WS_BV = 1 * MiB + 160 * 1024;
constexpr size_t WS_WIN = 2 * MiB, WS_WG = WS_WIN + (size_t)3328 * 1024 * 2, WS_WUQ = WS_WG + 4 * MiB, WS_WUK = 13 * MiB + 256 * 1024, WS_WUV = 13 * MiB + 512 * 1024;
constexpr size_t WS_W1 = 14 * MiB, WS_W2 = 15 * MiB, WS_WOUT = 16 * MiB, WS_WFF1 = 18 * MiB, WS_WFF2 = 26 * MiB;
constexpr size_t WS_H = 34 * MiB, WS_QLAT = 82 * MiB, WS_CKVA = 100 * MiB, WS_OMLA = 82 * MiB;
constexpr size_t WS_HQ = 113 * MiB, WS_KKF = 137 * MiB, WS_KKB = 161 * MiB, WS_HI = 185 * MiB, WS_HG = 209 * MiB, WS_SL = 233 * MiB, WS_DD = 249 * MiB;
constexpr size_t WS_G = 113 * MiB, WS_MERGED = 34 * MiB, WS_H2 = 82 * MiB, WS_HID = 130 * MiB;
constexpr size_t DO_Q = 0, DO_KN = 36 * MiB, DO_KR = 62 * MiB, DO_VTP = 64 * MiB, DO_VTS = 72 * MiB;
constexpr size_t OUT_CKV = 25165824, OUT_KROPE = 27262976, OUT_STATE = 27525120;
constexpr int LDS_BYTES = 147456;

__device__ __forceinline__ unsigned cvtpk(float lo, float hi) { f32x2 v = {lo, hi}; bf16x2_t b = __builtin_convertvector(v, bf16x2_t); return __builtin_bit_cast(unsigned, b); }
__device__ __forceinline__ float bf2f(unsigned short b) { return __uint_as_float(((unsigned)b) << 16); }
__device__ __forceinline__ float bflo(unsigned w) { return __uint_as_float(w << 16); }
__device__ __forceinline__ float bfhi(unsigned w) { return __uint_as_float(w & 0xffff0000u); }
__device__ __forceinline__ void st8(bf16_t* p, f32x4 a, f32x4 b) { u32x4 w; w.x = cvtpk(a[0], a[1]); w.y = cvtpk(a[2], a[3]); w.z = cvtpk(b[0], b[1]); w.w = cvtpk(b[2], b[3]); *(u32x4*)p = w; }
__device__ __forceinline__ float sigm(float v) { return __builtin_amdgcn_rcpf(1.f + __expf(-v)); }
__device__ __forceinline__ float silu(float v) { return v * sigm(v); }
__device__ __forceinline__ float wave_sum(float v) {
#pragma unroll
    for (int o = 1; o < 64; o <<= 1) v += __shfl_xor(v, o);
    return v;
}


#define XB_TMO      128
#define XB_XCNT(j)  (256  + 64 * (j))
#define XB_XSUB(j)  (1280 + 64 * (j))
#define XB_XGEN(j)  (2304 + 64 * (j))
#define XB_TOP      3328
#define XB_TOPGEN   3392
#define XCD_BAR_WORDS 3456
#define XB_SPIN_CAP (1u << 18)
__device__ __forceinline__ unsigned xb_ld(unsigned* p)              { return __hip_atomic_load(p, __ATOMIC_RELAXED, __HIP_MEMORY_SCOPE_AGENT); }
__device__ __forceinline__ unsigned xb_add(unsigned* p, unsigned v) { return __hip_atomic_fetch_add(p, v, __ATOMIC_RELAXED, __HIP_MEMORY_SCOPE_AGENT); }
__device__ __forceinline__ unsigned xb_xcc_id() { return (unsigned)__builtin_amdgcn_s_getreg((3 << 11) | 20) & 0xFu; }
#define XB_SPIN(cond, bar) do { unsigned _sp = 0; while (cond) { __builtin_amdgcn_s_sleep(1); \
    if ((++_sp & 255u) == 0u) { if (xb_ld(&(bar)[XB_TMO])) break; if (_sp > XB_SPIN_CAP) { atomicAdd(&(bar)[XB_TMO], 1u); break; } } } } while (0)
struct XcdBarrier { unsigned* bar; unsigned x; volatile LAS unsigned* st; };
__device__ __forceinline__ XcdBarrier xcd_barrier_post(unsigned* bar, volatile LAS unsigned* st) {
    XcdBarrier b; b.bar = bar; b.x = xb_xcc_id(); b.st = st;
    if (threadIdx.x == 0) (void)xb_add(&bar[XB_XCNT(b.x)], 1u);
    return b;
}
__device__ __forceinline__ void xcd_barrier_complete(unsigned* bar, unsigned x, unsigned& nloc, unsigned& nx) {
    const unsigned G = gridDim.x * gridDim.y * gridDim.z;
    unsigned sum, cnt, mine, sp = 0u;
    for (;;) {
        sum = 0u; cnt = 0u; mine = 0u;
#pragma unroll
        for (unsigned j = 0; j < 16; ++j) { const unsigned c = xb_ld(&bar[XB_XCNT(j)]); sum += c; cnt += (c > 0u) ? 1u : 0u; mine = (j == x) ? c : mine; }
        if (sum == G) break;
        __builtin_amdgcn_s_sleep(1);
        if ((++sp & 255u) == 0u) { if (xb_ld(&bar[XB_TMO])) break; if (sp > XB_SPIN_CAP) { atomicAdd(&bar[XB_TMO], 1u); break; } }
    }
    nloc = mine > 0u ? mine : 1u; nx = cnt > 0u ? cnt : 1u;
}
__device__ __forceinline__ void xcd_barrier(const XcdBarrier& b) {
    asm volatile("s_waitcnt vmcnt(0)" ::: "memory");
    __syncthreads();
    if (threadIdx.x == 0) {
        unsigned* bar = b.bar;
        __builtin_amdgcn_s_waitcnt(0);
        unsigned nloc = b.st[0], nx = b.st[1];
        if (nloc == 0u) { xcd_barrier_complete(bar, b.x, nloc, nx); b.st[0] = nloc; b.st[1] = nx; }
        const unsigned old = xb_add(&bar[XB_XSUB(b.x)], 1u);
        const unsigned gen = old / nloc;
        if (old + 1u == (gen + 1u) * nloc) {
            __builtin_amdgcn_fence(__ATOMIC_RELEASE, "agent");
            asm volatile("s_waitcnt vmcnt(0)" ::: "memory");
            const unsigned og = xb_add(&bar[XB_TOP], 1u);
            const unsigned tg = og / nx;
            if (og + 1u == (tg + 1u) * nx) xb_add(&bar[XB_TOPGEN], 1u);
            else XB_SPIN(xb_ld(&bar[XB_TOPGEN]) == tg, bar);
            __builtin_amdgcn_fence(__ATOMIC_ACQUIRE, "agent");
            xb_add(&bar[XB_XGEN(b.x)], 1u);
            asm volatile("s_waitcnt vmcnt(0)" ::: "memory");
        } else {
            XB_SPIN(xb_ld(&bar[XB_XGEN(b.x)]) == gen, bar);
            __builtin_amdgcn_fence(__ATOMIC_ACQUIRE, "agent");
            asm volatile("s_waitcnt vmcnt(0)" ::: "memory");
        }
    }
    __syncthreads();
}

namespace pg8 {
constexpr int BM = 256, BK = 64, HALF = 128, HTB = HALF * BK * 2, STAGE_BYTES = 8 * HTB;
__host__ __device__ __forceinline__ int lds_byte(int r, int c) { const int st = (r >> 4) * 2 + (c >> 5), rr = r & 15, cc = c & 31, ob = rr * 64 + cc * 2; return st * 1024 + (ob ^ (((ob >> 9) & 1) << 5)); }
__host__ __device__ __forceinline__ void stage_rc(int b, int& R, int& C) { const int st = b / 1024, sb = b % 1024, swz = sb ^ (((sb >> 9) & 1) << 5); R = (st >> 1) * 16 + swz / 64; C = (st & 1) * 32 + (swz % 64) / 2; }
__host__ __device__ __forceinline__ int perm32(int rho) { const int n = rho >> 4, i = rho & 15; return 8 * (i >> 2) + 4 * n + (i & 3); }
struct Unit { const char* A; const char* B; int pm, pn, flags; };

template <class Epi, class Sched>
__device__ __forceinline__ void gemm_phase(LAS unsigned char* lds, const int lda, const int ldb, const int K, const Sched& S, const Epi& E) {
    int tid_ = threadIdx.x; asm volatile("" : "+v"(tid_));
    const int tid = tid_, wid = __builtin_amdgcn_readfirstlane(tid >> 6), lane = tid & 63, wr = wid >> 2, wc = wid & 3, fr = lane & 15, fq = lane >> 4;
    const int nt = K / BK;
    unsigned voffA[2], voffB[2];
#pragma unroll
    for (int i = 0; i < 2; ++i) { int R, C; stage_rc(tid * 16 + i * 8192, R, C); const int Rb = Epi::PERM ? ((R & ~31) + perm32(R & 31)) : R;
        voffA[i] = (unsigned)(R * lda + C) * 2u; voffB[i] = (unsigned)(Rb * ldb + C) * 2u; }
    const size_t kstep = (size_t)(BK * 2);
    const size_t hstepA = (size_t)HALF * lda * 2, hstepB = (size_t)HALF * ldb * 2;
    const unsigned ldsw = (unsigned)wid * 1024u;
    const int aoff = lds_byte(wr * 64 + fr, fq * 8), boff = lds_byte(wc * 32 + fr, fq * 8);
#define PG8_SA(b, h) (((b) * 2 + (h)) * HTB)
#define PG8_SB(b, h) ((4 + (b) * 2 + (h)) * HTB)
#define PG8_STAGE(bufoff, gbase, voff) do { _Pragma("unroll") for (int _i = 0; _i < 2; ++_i) \
        __builtin_amdgcn_global_load_lds((const unsigned*)((const char*)(gbase) + (voff)[_i]), (LAS unsigned*)(lds + (bufoff) + ldsw + _i * 8192), 16, 0, 0); } while (0)
#define PG8_LDA(dst, b, h) do { _Pragma("unroll") for (int m = 0; m < 4; ++m) _Pragma("unroll") for (int k = 0; k < 2; ++k) dst[m][k] = *(const LAS bf16x8*)(lds + PG8_SA(b, h) + aoff + m * 2048 + k * 1024); } while (0)
#define PG8_LDB(dst, b, h) do { _Pragma("unroll") for (int n = 0; n < 2; ++n) _Pragma("unroll") for (int k = 0; k < 2; ++k) dst[n][k] = *(const LAS bf16x8*)(lds + PG8_SB(b, h) + boff + n * 2048 + k * 1024); } while (0)
#define PG8_MMA(ai, bj, At, Bt) do { __builtin_amdgcn_s_setprio(1); _Pragma("unroll") for (int m = 0; m < 4; ++m) _Pragma("unroll") for (int n = 0; n < 2; ++n) _Pragma("unroll") for (int k = 0; k < 2; ++k) \
        acc[ai][bj][m][n] = Epi::SWAP ? __builtin_amdgcn_mfma_f32_16x16x32_bf16(At[m][k], Bt[n][k], acc[ai][bj][m][n], 0, 0, 0) \
                                      : __builtin_amdgcn_mfma_f32_16x16x32_bf16(Bt[n][k], At[m][k], acc[ai][bj][m][n], 0, 0, 0); __builtin_amdgcn_s_setprio(0); } while (0)
#define PG8_WAIT_V(n) asm volatile("s_waitcnt vmcnt(" #n ")" ::: "memory")
#define PG8_WAIT_L(n) asm volatile("s_waitcnt lgkmcnt(" #n ")" ::: "memory")
#define PG8_BAR __builtin_amdgcn_s_barrier()
#define PG8_SCHED __builtin_amdgcn_sched_barrier(0)
    Unit cur, nxt; int ui = 0;
    if (!S.next(0, cur)) return;
    f32x4 acc[2][2][4][2];
#pragma unroll
    for (int a = 0; a < 2; ++a)
#pragma unroll
        for (int b = 0; b < 2; ++b)
#pragma unroll
            for (int m = 0; m < 4; ++m)
#pragma unroll
                for (int n = 0; n < 2; ++n) acc[a][b][m][n] = (f32x4){0.f, 0.f, 0.f, 0.f};
    bf16x8 At[4][2], B0[2][2], B1[2][2];
    const char* cA = cur.A; const char* cB = cur.B;
    PG8_STAGE(PG8_SB(0, 0), cB, voffB); PG8_STAGE(PG8_SB(0, 1), cB + hstepB, voffB); PG8_STAGE(PG8_SA(0, 0), cA, voffA); PG8_STAGE(PG8_SA(0, 1), cA + hstepA, voffA);
    if (wr == 1) PG8_BAR;
    PG8_WAIT_V(2); PG8_BAR;
    PG8_STAGE(PG8_SB(1, 0), cB + kstep, voffB); PG8_STAGE(PG8_SA(1, 0), cA + kstep, voffA); PG8_STAGE(PG8_SB(1, 1), cB + hstepB + kstep, voffB);
    PG8_WAIT_V(6); PG8_BAR;
    for (;;) {
        const bool has_next = S.next(ui + 1, nxt);
        const char* nA = has_next ? nxt.A : cA; const char* nB = has_next ? nxt.B : cB;
#pragma unroll 1
        for (int t = 0; t < nt; t += 2) {
            const bool last = (t == nt - 2);
            const char* a1 = cA + (size_t)(t + 1) * kstep;
            const char* a2 = last ? nA : cA + (size_t)(t + 2) * kstep; const char* b2 = last ? nB : cB + (size_t)(t + 2) * kstep;
            const char* a3 = a2 + kstep; const char* b3 = b2 + kstep;
            PG8_LDB(B0, 0, 0); PG8_LDB(B1, 0, 1); PG8_SCHED; PG8_LDA(At, 0, 0); PG8_STAGE(PG8_SA(1, 1), a1 + hstepA, voffA);
            PG8_WAIT_V(8); PG8_WAIT_L(0); PG8_BAR; PG8_MMA(0, 0, At, B0); PG8_MMA(0, 1, At, B1); PG8_BAR; PG8_SCHED;
            PG8_LDA(At, 0, 1); PG8_STAGE(PG8_SB(0, 0), b2, voffB); PG8_STAGE(PG8_SB(0, 1), b2 + hstepB, voffB); PG8_STAGE(PG8_SA(0, 0), a2, voffA);
            PG8_WAIT_V(8); PG8_WAIT_L(0); PG8_BAR; PG8_MMA(1, 0, At, B0); PG8_MMA(1, 1, At, B1); PG8_BAR; PG8_SCHED;
            PG8_LDB(B0, 1, 0); PG8_LDB(B1, 1, 1); PG8_SCHED; PG8_LDA(At, 1, 0); PG8_STAGE(PG8_SA(0, 1), a2 + hstepA, voffA);
            PG8_WAIT_V(8); PG8_WAIT_L(0); PG8_BAR; PG8_MMA(0, 0, At, B0); PG8_MMA(0, 1, At, B1); PG8_BAR; PG8_SCHED;
            PG8_LDA(At, 1, 1); PG8_STAGE(PG8_SB(1, 0), b3, voffB); PG8_STAGE(PG8_SB(1, 1), b3 + hstepB, voffB); PG8_STAGE(PG8_SA(1, 0), a3, voffA);
            PG8_WAIT_V(8); PG8_WAIT_L(0); PG8_BAR; PG8_MMA(1, 0, At, B0); PG8_MMA(1, 1, At, B1); PG8_BAR; PG8_SCHED;
        }
        if (wr == 0) PG8_BAR;
        E(acc, cur, wr, wc, fr, fq);
        if (!has_next) break;
        if (!(cur.flags & 1)) {
#pragma unroll
            for (int a = 0; a < 2; ++a)
#pragma unroll
                for (int b = 0; b < 2; ++b)
#pragma unroll
                    for (int m = 0; m < 4; ++m)
#pragma unroll
                        for (int n = 0; n < 2; ++n) acc[a][b][m][n] = (f32x4){0.f, 0.f, 0.f, 0.f};
        }
        cur = nxt; cA = nA; cB = nB; ++ui;
        if (wr == 1) PG8_BAR;
    }
    PG8_WAIT_V(0);
    PG8_BAR;
#undef PG8_SA
#undef PG8_SB
#undef PG8_STAGE
#undef PG8_LDA
#undef PG8_LDB
#undef PG8_MMA
#undef PG8_WAIT_V
#undef PG8_WAIT_L
#undef PG8_BAR
#undef PG8_SCHED
}
}
using pg8::Unit;

struct RangeSched {
    const char* A; const char* B; size_t tA, tB; int nN, n, first, G, pm0;
    __device__ __forceinline__ bool next(int i, Unit& u) const {
        const int idx = first + i * G; if (idx >= n) return false;
        const int pm = idx / nN, pn = idx - pm * nN;
        u.A = A + (size_t)pm * tA; u.B = B + (size_t)pn * tB; u.pm = pm + pm0; u.pn = pn; u.flags = 0; return true; }
};
struct MergeSched {
    const char *A0, *A1, *B0, *B1; size_t tA, tB; int n, c, G;
    __device__ __forceinline__ bool next(int i, Unit& u) const {
        const int tile = c + (i >> 1) * G; if (tile >= n) return false;
        const int seg = i & 1, pm = tile >> 2, pn = tile & 3;
        u.A = (seg ? A1 : A0) + (size_t)pm * tA; u.B = (seg ? B1 : B0) + (size_t)pn * tB; u.pm = pm; u.pn = pn; u.flags = seg ? 0 : 1; return true; }
};
__device__ __forceinline__ int first_of(int base, int c, int G) { return (((c - base) % G) + G) % G; }
__device__ __forceinline__ int key_row(int tok) { if (tok < TP) return tok; const int s = tok - TP; return TP + (s >> 12) * NKS + (s & 4095); }
__device__ __forceinline__ int cond_of(int tok) { return tok < TP ? 4 : ((tok - TP) >> 12); }

struct Ptrs {
    const float* in[24]; float* out; unsigned char* ws;
};

struct EpiIn {
    static constexpr bool PERM = true, SWAP = false;
    unsigned char* ws; float* out;
    __device__ __forceinline__ void operator()(f32x4 (&acc)[2][2][4][2], const Unit& u, int wr, int wc, int fr, int fq) const {
        const int pn = u.pn;
        float* rsq = (float*)(ws + WS_RSQ); float* rskv = (float*)(ws + WS_RSKV);
        const float* rope = (const float*)(ws + WS_ROPE); const float* lb1m = (const float*)(ws + WS_LB);
#pragma unroll
        for (int ai = 0; ai < 2; ++ai)
#pragma unroll
            for (int m = 0; m < 4; ++m) { asm volatile("" ::: "memory");
                const int row = u.pm * 256 + ai * 128 + wr * 64 + m * 16 + fr;
                if (pn == 0) {
                    const int kr = key_row(row); float ss = 0.f;
#pragma unroll
                    for (int bj = 0; bj < 2; ++bj) { const f32x4 v0 = acc[ai][bj][m][0], v1 = acc[ai][bj][m][1]; const int col = bj * 128 + wc * 32 + fq * 8;
                        ss += v0[0] * v0[0] + v0[1] * v0[1] + v0[2] * v0[2] + v0[3] * v0[3] + v1[0] * v1[0] + v1[1] * v1[1] + v1[2] * v1[2] + v1[3] * v1[3];
                        st8((bf16_t*)(ws + WS_CKVA) + (size_t)kr * 256 + col, v0, v1); }
                    ss += __shfl_xor(ss, 16); ss += __shfl_xor(ss, 32);
                    if (fq == 0) atomicAdd(rskv + kr, ss);
                } else if (pn <= 2) {
                    float ss = 0.f;
#pragma unroll
                    for (int bj = 0; bj < 2; ++bj) { const f32x4 v0 = acc[ai][bj][m][0], v1 = acc[ai][bj][m][1]; const int cb = (pn - 1) * 256 + bj * 128 + wc * 32;
                        if (cb < 384) {
                            ss += v0[0] * v0[0] + v0[1] * v0[1] + v0[2] * v0[2] + v0[3] * v0[3] + v1[0] * v1[0] + v1[1] * v1[1] + v1[2] * v1[2] + v1[3] * v1[3];
                            st8((bf16_t*)(ws + WS_QLAT) + (size_t)row * 384 + cb + fq * 8, v0, v1);
                        } else if (cb == 384) {
                            const int j0 = fq * 8; const int kr = key_row(row); bf16_t* krp = (bf16_t*)((unsigned char*)out + DO_KR) + (size_t)kr * 32 + j0;
                            if (row < TP) { float* o = out + OUT_KROPE + (size_t)row * 32 + j0; *(f32x4*)o = v0; *(f32x4*)(o + 4) = v1; st8(krp, v0, v1); }
                            else { const int pos = (row - TP) & 4095; const float* rp = rope + ((size_t)pos * 16 + fq * 4) * 2;
                                const f32x4 cs0 = *(const f32x4*)rp, cs1 = *(const f32x4*)(rp + 4);
                                f32x4 r0, r1;
                                r0[0] = v0[0] * cs0[0] - v0[1] * cs0[1]; r0[1] = v0[0] * cs0[1] + v0[1] * cs0[0];
                                r0[2] = v0[2] * cs0[2] - v0[3] * cs0[3]; r0[3] = v0[2] * cs0[3] + v0[3] * cs0[2];
                                r1[0] = v1[0] * cs1[0] - v1[1] * cs1[1]; r1[1] = v1[0] * cs1[1] + v1[1] * cs1[0];
                                r1[2] = v1[2] * cs1[2] - v1[3] * cs1[3]; r1[3] = v1[2] * cs1[3] + v1[3] * cs1[2];
                                st8(krp, r0, r1); }
                        } }
                    if (pn == 1 || true) { ss += __shfl_xor(ss, 16); ss += __shfl_xor(ss, 32); if (fq == 0 && ss != 0.f) atomicAdd(rsq + row, ss); }
                } else {
                    const int buf = (pn - 3) >> 1; bf16_t* base = (bf16_t*)(ws + WS_HQ + (size_t)buf * 24 * MiB) + (size_t)row * 512;
#pragma unroll
                    for (int bj = 0; bj < 2; ++bj) { f32x4 v0 = acc[ai][bj][m][0], v1 = acc[ai][bj][m][1]; const int col = ((pn - 3) & 1) * 256 + bj * 128 + wc * 32 + fq * 8;
                        if (buf == 0) {
#pragma unroll
                            for (int j = 0; j < 4; ++j) { v0[j] = silu(v0[j]) * 0.125f; v1[j] = silu(v1[j]) * 0.125f; }
                        } else if (buf == 1 || buf == 2) { const float* lp = lb1m + (buf - 1) * 512 + col; const f32x4 l0 = *(const f32x4*)lp, l1 = *(const f32x4*)(lp + 4);
#pragma unroll
                            for (int j = 0; j < 4; ++j) { v0[j] = l0[j] * sigm(-v0[j]); v1[j] = l1[j] * sigm(-v1[j]); }
                        } else if (buf == 4) {
#pragma unroll
                            for (int j = 0; j < 4; ++j) { v0[j] = silu(v0[j]); v1[j] = silu(v1[j]); }
                        }
                        st8(base + col, v0, v1); }
                }
            }
    }
};
struct EpiQ {
    static constexpr bool PERM = true, SWAP = false;
    unsigned char* ws; float* out;
    __device__ __forceinline__ void operator()(f32x4 (&acc)[2][2][4][2], const Unit& u, int wr, int wc, int fr, int fq) const {
        const float* rsq = (const float*)(ws + WS_RSQ); const float* rope = (const float*)(ws + WS_ROPE);
        bf16_t* Q = (bf16_t*)((unsigned char*)out + DO_Q);
        float rsv[2][4];
#pragma unroll
        for (int ai = 0; ai < 2; ++ai)
#pragma unroll
            for (int m = 0; m < 4; ++m) rsv[ai][m] = rsq[u.pm * 256 + ai * 128 + wr * 64 + m * 16 + fr];
#pragma unroll
        for (int ai = 0; ai < 2; ++ai)
#pragma unroll
            for (int m = 0; m < 4; ++m) { asm volatile("" ::: "memory");
                const int row = u.pm * 256 + ai * 128 + wr * 64 + m * 16 + fr;
                const float r = __builtin_amdgcn_rsqf(rsv[ai][m] * (1.f / 384.f) + EPS) * QSCALE;
#pragma unroll
                for (int bj = 0; bj < 2; ++bj) { f32x4 v0 = acc[ai][bj][m][0] * r, v1 = acc[ai][bj][m][1] * r; const int col = u.pn * 256 + bj * 128 + wc * 32 + fq * 8;
                    const int d = col % 96;
                    if (d >= 64 && row >= TP) { const int pos = (row - TP) & 4095; const float* rp = rope + ((size_t)pos * 16 + ((d - 64) >> 1)) * 2;
                        const f32x4 cs0 = *(const f32x4*)rp, cs1 = *(const f32x4*)(rp + 4); f32x4 r0, r1;
                        r0[0] = v0[0] * cs0[0] - v0[1] * cs0[1]; r0[1] = v0[0] * cs0[1] + v0[1] * cs0[0];
                        r0[2] = v0[2] * cs0[2] - v0[3] * cs0[3]; r0[3] = v0[2] * cs0[3] + v0[3] * cs0[2];
                        r1[0] = v1[0] * cs1[0] - v1[1] * cs1[1]; r1[1] = v1[0] * cs1[1] + v1[1] * cs1[0];
                        r1[2] = v1[2] * cs1[2] - v1[3] * cs1[3]; r1[3] = v1[2] * cs1[3] + v1[3] * cs1[2];
                        v0 = r0; v1 = r1; }
                    st8(Q + (size_t)row * 768 + col, v0, v1); }
            }
    }
};
__device__ __forceinline__ bool ctx_tile(int pm) { return pm >= 32 && ((pm - 32) % 18) >= 16; }
__device__ __forceinline__ float rkv_of(const float* rskv, int kr, bool ctx) { return ctx ? 1.f : __builtin_amdgcn_rsqf(rskv[kr] * (1.f / 256.f) + EPS); }
struct EpiK {
    static constexpr bool PERM = true, SWAP = false;
    unsigned char* ws; float* out;
    __device__ __forceinline__ void operator()(f32x4 (&acc)[2][2][4][2], const Unit& u, int wr, int wc, int fr, int fq) const {
        const float* rskv = (const float*)(ws + WS_RSKV); bf16_t* Kn = (bf16_t*)((unsigned char*)out + DO_KN); const bool ctx = ctx_tile(u.pm);
        float rsv[2][4];
#pragma unroll
        for (int ai = 0; ai < 2; ++ai)
#pragma unroll
            for (int m = 0; m < 4; ++m) rsv[ai][m] = rkv_of(rskv, u.pm * 256 + ai * 128 + wr * 64 + m * 16 + fr, ctx);
#pragma unroll
        for (int ai = 0; ai < 2; ++ai)
#pragma unroll
            for (int m = 0; m < 4; ++m) { asm volatile("" ::: "memory");
                const int row = u.pm * 256 + ai * 128 + wr * 64 + m * 16 + fr; const float r = rsv[ai][m];
#pragma unroll
                for (int bj = 0; bj < 2; ++bj) { const int col = u.pn * 256 + bj * 128 + wc * 32 + fq * 8; st8(Kn + (size_t)row * 512 + col, acc[ai][bj][m][0] * r, acc[ai][bj][m][1] * r); }
            }
    }
};
struct EpiV {
    static constexpr bool PERM = false, SWAP = true;
    unsigned char* ws; float* out;
    __device__ __forceinline__ void operator()(f32x4 (&acc)[2][2][4][2], const Unit& u, int wr, int wc, int fr, int fq) const {
        const float* rskv = (const float*)(ws + WS_RSKV); const bool ctx = ctx_tile(u.pm);
        f32x4 rq[2][4];
#pragma unroll
        for (int ai = 0; ai < 2; ++ai)
#pragma unroll
            for (int m = 0; m < 4; ++m) rq[ai][m] = ctx ? (f32x4){1.f, 1.f, 1.f, 1.f} : *(const f32x4*)(rskv + u.pm * 256 + ai * 128 + wr * 64 + m * 16 + fq * 4);
#pragma unroll
        for (int ai = 0; ai < 2; ++ai)
#pragma unroll
            for (int m = 0; m < 4; ++m) { asm volatile("" ::: "memory");
                const int kr = u.pm * 256 + ai * 128 + wr * 64 + m * 16 + fq * 4;
                f32x4 r4 = {1.f, 1.f, 1.f, 1.f}; if (!ctx) { r4 = rq[ai][m]; r4[0] = __builtin_amdgcn_rsqf(r4[0] * (1.f / 256.f) + EPS); r4[1] = __builtin_amdgcn_rsqf(r4[1] * (1.f / 256.f) + EPS); r4[2] = __builtin_amdgcn_rsqf(r4[2] * (1.f / 256.f) + EPS); r4[3] = __builtin_amdgcn_rsqf(r4[3] * (1.f / 256.f) + EPS); }
                const float r0 = r4[0], r1 = r4[1], r2 = r4[2], r3 = r4[3];
                bf16_t* base; int nk, key;
                if (u.pm < 32) { base = (bf16_t*)((unsigned char*)out + DO_VTP) + (size_t)u.pm * 8 * 64 * 256; nk = 256; key = kr & 255; }
                else { const int b = (u.pm - 32) / 18; base = (bf16_t*)((unsigned char*)out + DO_VTS) + (size_t)b * 8 * 64 * NKS; nk = NKS; key = kr - TP - b * NKS; }
#pragma unroll
                for (int bj = 0; bj < 2; ++bj)
#pragma unroll
                    for (int n = 0; n < 2; ++n) { const int col = u.pn * 256 + bj * 128 + wc * 32 + n * 16 + fr; const f32x4 v = acc[ai][bj][m][n];
                        u32x2 w; w.x = cvtpk(v[0] * r0, v[1] * r1); w.y = cvtpk(v[2] * r2, v[3] * r3);
                        *(u32x2*)(base + (size_t)col * nk + key) = w; }
            }
    }
};
struct EpiGate {
    static constexpr bool PERM = true, SWAP = false;
    unsigned char* ws;
    __device__ __forceinline__ void operator()(f32x4 (&acc)[2][2][4][2], const Unit& u, int wr, int wc, int fr, int fq) const {
        bf16_t* G = (bf16_t*)(ws + WS_G);
#pragma unroll
        for (int ai = 0; ai < 2; ++ai)
#pragma unroll
            for (int m = 0; m < 4; ++m) { asm volatile("" ::: "memory"); const int row = u.pm * 256 + ai * 128 + wr * 64 + m * 16 + fr;
#pragma unroll
                for (int bj = 0; bj < 2; ++bj) { f32x4 v0 = acc[ai][bj][m][0], v1 = acc[ai][bj][m][1]; const int col = u.pn * 256 + bj * 128 + wc * 32 + fq * 8;
#pragma unroll
                    for (int j = 0; j < 4; ++j) { v0[j] = sigm(v0[j]); v1[j] = sigm(v1[j]); }
                    st8(G + (size_t)row * 2048 + col, v0, v1); } }
    }
};
struct EpiMerge {
    static constexpr bool PERM = true, SWAP = false;
    unsigned char* ws;
    __device__ __forceinline__ void operator()(f32x4 (&acc)[2][2][4][2], const Unit& u, int wr, int wc, int fr, int fq) const {
        const bf16_t* G = (const bf16_t*)(ws + WS_G); bf16_t* MG = (bf16_t*)(ws + WS_MERGED);
        const bool hook = u.flags & 1;
#pragma unroll
        for (int ai = 0; ai < 2; ++ai) { asm volatile("" ::: "memory");
            u32x4 gbv[4][2], gav[4][2];
#pragma unroll
            for (int m = 0; m < 4; ++m) { const int row = u.pm * 256 + ai * 128 + wr * 64 + m * 16 + fr;
#pragma unroll
                for (int bj = 0; bj < 2; ++bj) { const int col = u.pn * 256 + bj * 128 + wc * 32 + fq * 8;
                    gbv[m][bj] = *(const u32x4*)(G + (size_t)row * 2048 + 1024 + col);
                    if (hook) gav[m][bj] = *(const u32x4*)(G + (size_t)row * 2048 + col); else gav[m][bj] = gbv[m][bj]; } }
#pragma unroll
            for (int m = 0; m < 4; ++m) { const int row = u.pm * 256 + ai * 128 + wr * 64 + m * 16 + fr;
#pragma unroll
                for (int bj = 0; bj < 2; ++bj) { const int col = u.pn * 256 + bj * 128 + wc * 32 + fq * 8;
                    const u32x4 gb = gbv[m][bj], ga = gav[m][bj];
                    f32x4 b0 = {bflo(gb.x), bfhi(gb.x), bflo(gb.y), bfhi(gb.y)}, b1 = {bflo(gb.z), bfhi(gb.z), bflo(gb.w), bfhi(gb.w)};
                    if (hook) {
                        f32x4 a0 = {bflo(ga.x), bfhi(ga.x), bflo(ga.y), bfhi(ga.y)}, a1 = {bflo(ga.z), bfhi(ga.z), bflo(ga.w), bfhi(ga.w)};
#pragma unroll
                        for (int j = 0; j < 4; ++j) { acc[ai][bj][m][0][j] *= a0[j] * __builtin_amdgcn_rcpf(fmaxf(b0[j], 1e-30f)); acc[ai][bj][m][1][j] *= a1[j] * __builtin_amdgcn_rcpf(fmaxf(b1[j], 1e-30f)); }
                    } else st8(MG + (size_t)row * 1024 + col, acc[ai][bj][m][0] * b0, acc[ai][bj][m][1] * b1); } } }
    }
};
struct EpiRes {
    static constexpr bool PERM = true, SWAP = false;
    const float* xp; const float* xs; float* out; const float* gate;
    bf16_t* h2a; const float* gff; float* rs2;
    __device__ __forceinline__ void operator()(f32x4 (&acc)[2][2][4][2], const Unit& u, int wr, int wc, int fr, int fq) const {
        const float* md = gate - (xp ? 2 * 1024 : 5 * 1024) + (size_t)cond_of(u.pm * 256) * 6144;
        const float* g = md + (xp ? 2 * 1024 : 5 * 1024);
        f32x4 gv[2][2], gm[2][2];
#pragma unroll
        for (int bj = 0; bj < 2; ++bj) { const int col = u.pn * 256 + bj * 128 + wc * 32 + fq * 8; gv[bj][0] = *(const f32x4*)(g + col); gv[bj][1] = *(const f32x4*)(g + col + 4);
            if (h2a) { gm[bj][0] = *(const f32x4*)(gff + col) * (1.f + *(const f32x4*)(md + 4 * 1024 + col)); gm[bj][1] = *(const f32x4*)(gff + col + 4) * (1.f + *(const f32x4*)(md + 4 * 1024 + col + 4)); } }
#pragma unroll
        for (int ai = 0; ai < 2; ++ai)
#pragma unroll
          for (int mh = 0; mh < 2; ++mh) { asm volatile("" ::: "memory");
            f32x4 xv[2][2][2];
#pragma unroll
            for (int m2 = 0; m2 < 2; ++m2) { const int row = u.pm * 256 + ai * 128 + wr * 64 + (mh * 2 + m2) * 16 + fr;
                const float* bp = xp ? (row < TP ? xp + (size_t)row * 1024 : xs + (size_t)(row - TP) * 1024) : out + (size_t)row * 1024;
#pragma unroll
                for (int bj = 0; bj < 2; ++bj) { const int col = u.pn * 256 + bj * 128 + wc * 32 + fq * 8; xv[m2][bj][0] = *(const f32x4*)(bp + col); xv[m2][bj][1] = *(const f32x4*)(bp + col + 4); } }
#pragma unroll
            for (int m2 = 0; m2 < 2; ++m2) { const int m = mh * 2 + m2; const int row = u.pm * 256 + ai * 128 + wr * 64 + m * 16 + fr; float* op = out + (size_t)row * 1024; float ss = 0.f;
#pragma unroll
                for (int bj = 0; bj < 2; ++bj) { const int col = u.pn * 256 + bj * 128 + wc * 32 + fq * 8;
                    const f32x4 y0 = xv[m2][bj][0] + gv[bj][0] * acc[ai][bj][m][0], y1 = xv[m2][bj][1] + gv[bj][1] * acc[ai][bj][m][1];
                    *(f32x4*)(op + col) = y0; *(f32x4*)(op + col + 4) = y1;
                    if (h2a) { ss += y0[0] * y0[0] + y0[1] * y0[1] + y0[2] * y0[2] + y0[3] * y0[3] + y1[0] * y1[0] + y1[1] * y1[1] + y1[2] * y1[2] + y1[3] * y1[3];
                        st8(h2a + (size_t)row * 1024 + col, y0 * gm[bj][0], y1 * gm[bj][1]); } }
                if (h2a) { ss += __shfl_xor(ss, 16); ss += __shfl_xor(ss, 32); if (fq == 0) atomicAdd(rs2 + row, ss); } } }
    }
};
struct EpiFF1 {
    static constexpr bool PERM = true, SWAP = false;
    unsigned char* ws; int row0;
    __device__ __forceinline__ void operator()(f32x4 (&acc)[2][2][4][2], const Unit& u, int wr, int wc, int fr, int fq) const {
        bf16_t* HID = (bf16_t*)(ws + WS_HID); const float* rs2 = (const float*)(ws + WS_RS2);
        const float* bvp = (const float*)(ws + WS_BV) + (size_t)cond_of(u.pm * 256) * 4096;
        f32x4 bv[2][2]; float rsv[2][4];
#pragma unroll
        for (int bj = 0; bj < 2; ++bj) { const int col = u.pn * 256 + bj * 128 + wc * 32 + fq * 8; bv[bj][0] = *(const f32x4*)(bvp + col); bv[bj][1] = *(const f32x4*)(bvp + col + 4); }
#pragma unroll
        for (int ai = 0; ai < 2; ++ai)
#pragma unroll
            for (int m = 0; m < 4; ++m) rsv[ai][m] = rs2[u.pm * 256 + ai * 128 + wr * 64 + m * 16 + fr];
#pragma unroll
        for (int ai = 0; ai < 2; ++ai)
#pragma unroll
            for (int m = 0; m < 4; ++m) { asm volatile("" ::: "memory"); const int row = u.pm * 256 + ai * 128 + wr * 64 + m * 16 + fr - row0;
                const float r = __builtin_amdgcn_rsqf(rsv[ai][m] * (1.f / 1024.f) + EPS);
#pragma unroll
                for (int bj = 0; bj < 2; ++bj) { f32x4 v0 = acc[ai][bj][m][0] * r + bv[bj][0], v1 = acc[ai][bj][m][1] * r + bv[bj][1]; const int col = u.pn * 256 + bj * 128 + wc * 32 + fq * 8;
#pragma unroll
                    for (int j = 0; j < 4; ++j) { const float a = fmaxf(v0[j], 0.f), b = fmaxf(v1[j], 0.f); v0[j] = a * a; v1[j] = b * b; }
                    st8(HID + (size_t)row * 4096 + col, v0, v1); } }
    }
};

#define MFMA32(a, b, c) __builtin_amdgcn_mfma_f32_32x32x16_bf16((a), (b), (c), 0, 0, 0)
__device__ __forceinline__ bf16x8 pack8(const f32x16& a, int o) { u32x4 w; w.x = cvtpk(a[o], a[o + 1]); w.y = cvtpk(a[o + 2], a[o + 3]); w.z = cvtpk(a[o + 4], a[o + 5]); w.w = cvtpk(a[o + 6], a[o + 7]); return __builtin_bit_cast(bf16x8, w); }
constexpr int AT_KP = 208, AT_VP = 144, AT_KB = 64 * AT_KP, AT_BUF = AT_KB + 64 * AT_VP;
__device__ __forceinline__ void attn_unit(unsigned char* sm, const bf16_t* Qg, const bf16_t* Kn, const bf16_t* KR, const bf16_t* Vt, int NK, int head, bf16_t* Og) {
    int tid_ = threadIdx.x; asm volatile("" : "+v"(tid_));
    const int tid = tid_, lane = tid & 63, wid = tid >> 6, x = lane & 31, hh = lane >> 5;
    const int sig = (x & ~12) | ((x & 4) << 1) | ((x & 8) >> 1);
    bf16x8 qf[6];
    { const bf16_t* qp = Qg + (size_t)(wid * 32 + x) * 768 + head * 96 + hh * 8;
#pragma unroll
      for (int d0 = 0; d0 < 6; ++d0) qf[d0] = *(const bf16x8*)(qp + d0 * 16); }
    const int kkey = tid >> 3, kc = tid & 7, rkey = (tid & 255) >> 2, rc = tid & 3;
    const bf16_t* kp = Kn + (size_t)kkey * 512 + head * 64 + kc * 8;
    const bf16_t* rp = KR + (size_t)rkey * 32 + rc * 8;
    const bf16_t* vp = Vt + (size_t)kkey * NK + kc * 8;
    const int kdst = kkey * AT_KP + kc * 16, rdst = rkey * AT_KP + 128 + rc * 16, vdst = AT_KB + kkey * AT_VP + kc * 16;
    const int NT = NK >> 6;
    unsigned char* cur = sm; unsigned char* nx = sm + AT_BUF; unsigned char* wr = sm + 2 * AT_BUF;
    u32x4 gk, gr, gv;
    gk = *(const u32x4*)kp; gv = *(const u32x4*)vp; gr = *(const u32x4*)rp;
    *(u32x4*)(cur + kdst) = gk; *(u32x4*)(cur + vdst) = gv; *(u32x4*)(cur + rdst) = gr;
    { const size_t k1 = (NT > 1) ? 64 : 0; gk = *(const u32x4*)(kp + k1 * 512); gv = *(const u32x4*)(vp + k1); gr = *(const u32x4*)(rp + k1 * 32); }
    *(u32x4*)(nx + kdst) = gk; *(u32x4*)(nx + vdst) = gv; *(u32x4*)(nx + rdst) = gr;
    __syncthreads();
    f32x16 c0 = {}, c1 = {};
    { const unsigned char* ka = cur + sig * AT_KP + hh * 16;
#pragma unroll
      for (int d0 = 0; d0 < 6; ++d0) { const bf16x8 a0 = *(const bf16x8*)(ka + d0 * 32), a1 = *(const bf16x8*)(ka + 32 * AT_KP + d0 * 32); c0 = MFMA32(a0, qf[d0], c0); c1 = MFMA32(a1, qf[d0], c1); } }
    f32x16 o0 = {}, o1 = {};
    float mref = 0.f, lrun = 0.f; f32x16 negm = {};
#define AT_SB() __builtin_amdgcn_sched_barrier(0)
#define AT_LDK(d0, A0, A1) A0 = *(const bf16x8*)(ka + (d0) * 32); A1 = *(const bf16x8*)(ka + 32 * AT_KP + (d0) * 32);
#define AT_EXP8(C, o) _Pragma("unroll") for (int i = (o); i < (o) + 8; ++i) { C[i] = __builtin_amdgcn_exp2f(C[i]); }
#pragma unroll 1
    for (int t = 0; t < NT; ++t) {
        { const int t2 = (t + 2 < NT) ? t + 2 : NT - 1; const size_t k2 = (size_t)t2 * 64; gk = *(const u32x4*)(kp + k2 * 512); gv = *(const u32x4*)(vp + k2); gr = *(const u32x4*)(rp + k2 * 32); }
        const unsigned char* ka = nx + sig * AT_KP + hh * 16;
        const unsigned char* va = cur + AT_KB + x * AT_VP + hh * 16; const unsigned char* vb = va + 32 * AT_VP;
        bf16x8 fa0, fa1, fb0, fb1;
        AT_LDK(0, fa0, fa1);
        {
            float mx = fmaxf(fmaxf(c0[0], c1[0]), fmaxf(c0[1], c1[1]));
#pragma unroll
            for (int i = 2; i < 16; i += 2) mx = fmaxf(mx, fmaxf(fmaxf(c0[i], c1[i]), fmaxf(c0[i + 1], c1[i + 1])));
            auto rr = __builtin_amdgcn_permlane32_swap(__float_as_uint(mx), __float_as_uint(mx), false, false);
            mx = fmaxf(__uint_as_float(rr[0]), __uint_as_float(rr[1]));
            if (__any(mx > 8.f) || t == 0) {
                const float dl = (t == 0) ? mx : fmaxf(mx, 0.f); mref += dl; const float alpha = __builtin_amdgcn_exp2f(-dl); lrun *= alpha;
#pragma unroll
                for (int i = 0; i < 16; ++i) { c0[i] -= dl; c1[i] -= dl; o0[i] *= alpha; o1[i] *= alpha; negm[i] = -mref; }
            }
        }
        AT_SB();
        f32x16 n0, n1;
        AT_LDK(1, fb0, fb1); n0 = MFMA32(fa0, qf[0], negm); n1 = MFMA32(fa1, qf[0], negm);
        AT_EXP8(c0, 0)
        AT_SB();
        AT_LDK(2, fa0, fa1); n0 = MFMA32(fb0, qf[1], n0); n1 = MFMA32(fb1, qf[1], n1);
        AT_EXP8(c0, 8)
        AT_SB();
        AT_LDK(3, fb0, fb1); n0 = MFMA32(fa0, qf[2], n0); n1 = MFMA32(fa1, qf[2], n1);
        AT_EXP8(c1, 0)
        AT_SB();
        AT_LDK(4, fa0, fa1); n0 = MFMA32(fb0, qf[3], n0); n1 = MFMA32(fb1, qf[3], n1);
        AT_EXP8(c1, 8)
        AT_SB();
        AT_LDK(5, fb0, fb1); n0 = MFMA32(fa0, qf[4], n0); n1 = MFMA32(fa1, qf[4], n1);
        const bf16x8 v00 = *(const bf16x8*)(va), v01 = *(const bf16x8*)(va + 32), v02 = *(const bf16x8*)(va + 64), v03 = *(const bf16x8*)(va + 96);
        f32x2 rs2 = {0.f, 0.f};
#pragma unroll
        for (int i = 0; i < 16; i += 2) { rs2 += (f32x2){c0[i], c0[i + 1]}; rs2 += (f32x2){c1[i], c1[i + 1]}; }
        lrun += rs2[0] + rs2[1];
        AT_SB();
        n0 = MFMA32(fb0, qf[5], n0); n1 = MFMA32(fb1, qf[5], n1);
        const bf16x8 p00 = pack8(c0, 0), p01 = pack8(c0, 8), p10 = pack8(c1, 0), p11 = pack8(c1, 8);
        AT_SB();
        const bf16x8 v10 = *(const bf16x8*)(vb), v11 = *(const bf16x8*)(vb + 32), v12 = *(const bf16x8*)(vb + 64), v13 = *(const bf16x8*)(vb + 96);
        o0 = MFMA32(v00, p00, o0); o0 = MFMA32(v01, p01, o0); o0 = MFMA32(v02, p10, o0); o0 = MFMA32(v03, p11, o0);
        o1 = MFMA32(v10, p00, o1); o1 = MFMA32(v11, p01, o1); o1 = MFMA32(v12, p10, o1); o1 = MFMA32(v13, p11, o1);
        *(u32x4*)(wr + kdst) = gk; *(u32x4*)(wr + vdst) = gv; *(u32x4*)(wr + rdst) = gr;
        __syncthreads();
        c0 = n0; c1 = n1;
        { unsigned char* tmp = cur; cur = nx; nx = wr; wr = tmp; }
    }
#undef AT_SB
#undef AT_LDK
#undef AT_EXP8
    const float ltot = lrun + __shfl_xor(lrun, 32); const float inv = 1.f / ltot;
    bf16_t* op = Og + (size_t)(wid * 32 + x) * 512 + head * 64 + hh * 4;
#pragma unroll
    for (int g = 0; g < 4; ++g) {
        u32x2 w; w.x = cvtpk(o0[4 * g] * inv, o0[4 * g + 1] * inv); w.y = cvtpk(o0[4 * g + 2] * inv, o0[4 * g + 3] * inv); *(u32x2*)(op + 8 * g) = w;
        u32x2 w2; w2.x = cvtpk(o1[4 * g] * inv, o1[4 * g + 1] * inv); w2.y = cvtpk(o1[4 * g + 2] * inv, o1[4 * g + 3] * inv); *(u32x2*)(op + 32 + 8 * g) = w2; }
    __syncthreads();
}

constexpr int HW_QP = 0, HW_KP = 4608, HW_KET = 9216, HW_VT = 14336, HW_DEC = 19456, HW_DEC2 = 19712, HW_BYTES = 19968;
__device__ __forceinline__ int sig5(int k) { return (k & ~12) | ((k & 4) << 1) | ((k & 8) >> 1); }
__device__ __forceinline__ void st_bf16(unsigned char* p, float v) { *(bf16_t*)p = (bf16_t)(cvtpk(v, 0.f) & 0xffffu); }
#define WAVE_LDS_SYNC() asm volatile("s_waitcnt lgkmcnt(0)" ::: "memory")

template <bool FULL, int dir>
__device__ __forceinline__ void hg_chain(unsigned char* wl, const bf16_t* KK, const bf16_t* HQ, const bf16_t* HI, bf16_t* OD, size_t row0, int head, int lane,
                                         const float* s0, const float* SLf, const float* DDf, int nfold, int foldstep, float* so, float* ddo) {
    const int x = lane & 31, hh = lane >> 5, sk2 = sig5(lane) * 2, sx = sig5(x);
    f32x16 S[2][2] = {}; float Dtot = 1.f;
    if (s0) {
#pragma unroll
        for (int kb = 0; kb < 2; ++kb)
#pragma unroll
            for (int vb = 0; vb < 2; ++vb)
#pragma unroll
                for (int r = 0; r < 16; ++r) S[kb][vb][r] = s0[(32 * kb + (r & 3) + 8 * (r >> 2) + 4 * hh) * 64 + 32 * vb + x];
        for (int j = 0; j < nfold; ++j) { const float* SL = SLf + (ptrdiff_t)j * foldstep * 4096; const float* DD = DDf + (ptrdiff_t)j * foldstep * 64;
#pragma unroll
            for (int kb = 0; kb < 2; ++kb)
#pragma unroll
                for (int g = 0; g < 4; ++g) { const f32x4 d4 = *(const f32x4*)(DD + 32 * kb + 8 * g + 4 * hh);
#pragma unroll
                    for (int vb = 0; vb < 2; ++vb)
#pragma unroll
                        for (int q = 0; q < 4; ++q) S[kb][vb][4 * g + q] = fmaf(d4[q], S[kb][vb][4 * g + q], SL[(32 * kb + 8 * g + 4 * hh + q) * 64 + 32 * vb + x]); } }
    }
    const unsigned cbase = (unsigned)(row0 * 512) + (unsigned)head * 64u + (unsigned)lane;
#pragma unroll 1
    for (int c = 0; c < 8; ++c) {
        unsigned kpk[16], vpk[16]; float dec;
#define TOKOFF(p) ((unsigned)(dir ? 255 - (p) : (p)) * 512u)
        if (FULL) {
            float R = 1.f; float Kh[16];
#pragma unroll
            for (int s = 16; s < 32; ++s) { const unsigned off = cbase + TOKOFF(32 * c + s); const float kkv = bf2f(KK[off]), qv = bf2f(HQ[off]); const unsigned vv = HI[off];
                const float f = 1.f - kkv; R *= f; const float Ri = __builtin_amdgcn_rcpf(fmaxf(R, 1e-30f));
                Kh[s - 16] = kkv * Ri; st_bf16(wl + HW_QP + s * 144 + sk2, qv * R); st_bf16(wl + HW_KP + s * 144 + sk2, Kh[s - 16]);
                if (s & 1) vpk[s >> 1] |= vv << 16; else vpk[s >> 1] = vv;
                if ((s & 7) == 7) __builtin_amdgcn_sched_barrier(0); }
#pragma unroll
            for (int j = 0; j < 8; ++j) kpk[8 + j] = cvtpk(Kh[2 * j] * R, Kh[2 * j + 1] * R);
            float M = 1.f, keh = 0.f;
#pragma unroll
            for (int s = 15; s >= 0; --s) { const unsigned off = cbase + TOKOFF(32 * c + s); const float kkv = bf2f(KK[off]), qv = bf2f(HQ[off]); const unsigned vv = HI[off];
                const float f = 1.f - kkv; const float Mi = __builtin_amdgcn_rcpf(fmaxf(M, 1e-30f));
                const float kd = kkv * M; st_bf16(wl + HW_QP + s * 144 + sk2, qv * Mi); st_bf16(wl + HW_KP + s * 144 + sk2, kd);
                if (s & 1) { vpk[s >> 1] = vv << 16; keh = kd * R; } else { vpk[s >> 1] |= vv; kpk[s >> 1] = cvtpk(kd * R, keh); }
                M *= f;
                if ((s & 7) == 0) __builtin_amdgcn_sched_barrier(0); }
            dec = M * R;
            *(float*)(wl + HW_DEC2 + lane * 4) = M;
        } else {
            float Pd = 1.f, keh = 0.f;
#pragma unroll
            for (int s = 31; s >= 0; --s) { const unsigned off = cbase + TOKOFF(32 * c + s); const float kkv = bf2f(KK[off]); const unsigned vv = HI[off];
                const float ke = kkv * Pd; Pd *= 1.f - kkv;
                if (s & 1) { vpk[s >> 1] = vv << 16; keh = ke; } else { vpk[s >> 1] |= vv; kpk[s >> 1] = cvtpk(ke, keh); }
                if ((s & 7) == 0) __builtin_amdgcn_sched_barrier(0); }
            dec = Pd;
        }
        Dtot *= dec;
#pragma unroll
        for (int j = 0; j < 4; ++j) { u32x4 w; w.x = kpk[4 * j]; w.y = kpk[4 * j + 1]; w.z = kpk[4 * j + 2]; w.w = kpk[4 * j + 3]; *(u32x4*)(wl + HW_KET + lane * 80 + j * 16) = w;
            u32x4 wv; wv.x = vpk[4 * j]; wv.y = vpk[4 * j + 1]; wv.z = vpk[4 * j + 2]; wv.w = vpk[4 * j + 3]; *(u32x4*)(wl + HW_VT + lane * 80 + j * 16) = wv; }
        *(float*)(wl + HW_DEC + lane * 4) = dec;
        WAVE_LDS_SYNC();
        const unsigned char* vt0 = wl + HW_VT + x * 80 + hh * 16; const unsigned char* vt1 = vt0 + 32 * 80;
        if (FULL) {
            f32x16 at = {};
            const unsigned char* kp = wl + HW_KP + sx * 144 + hh * 16; const unsigned char* qp = wl + HW_QP + x * 144 + hh * 16;
#pragma unroll
            for (int ks = 0; ks < 4; ++ks) at = MFMA32(*(const bf16x8*)(kp + ks * 32), *(const bf16x8*)(qp + ks * 32), at);
            { int xo = x - 8 * hh; asm volatile("" : "+v"(xo));
#pragma unroll
              for (int r = 0; r < 16; ++r) { const int sv = (r & 3) + 4 * ((r >> 2) & 1) + 16 * (r >> 3); if (sv > xo) at[r] = 0.f; } }
            const bf16x8 pa0 = pack8(at, 0), pa1 = pack8(at, 8);
            const size_t orow = (row0 + (size_t)(dir ? 255 - (32 * c + x) : (32 * c + x))) * 512 + (size_t)head * 64 + hh * 4;
#pragma unroll
            for (int vb = 0; vb < 2; ++vb) { const unsigned char* vt = vb ? vt1 : vt0;
                f32x16 o = {};
                o = MFMA32(*(const bf16x8*)(vt), pa0, o); o = MFMA32(*(const bf16x8*)(vt + 32), pa1, o);
#pragma unroll
                for (int kb = 0; kb < 2; ++kb) { f32x16 sm_;
#pragma unroll
                    for (int g = 0; g < 4; ++g) { const f32x4 m4 = *(const f32x4*)(wl + HW_DEC2 + (32 * kb + 8 * g + 4 * hh) * 4);
#pragma unroll
                        for (int q = 0; q < 4; ++q) sm_[4 * g + q] = S[kb][vb][4 * g + q] * m4[q]; }
                    o = MFMA32(pack8(sm_, 0), *(const bf16x8*)(qp + kb * 64), o); o = MFMA32(pack8(sm_, 8), *(const bf16x8*)(qp + kb * 64 + 32), o); }
#pragma unroll
                for (int g = 0; g < 4; ++g) { u32x2 w; w.x = cvtpk(o[4 * g], o[4 * g + 1]); w.y = cvtpk(o[4 * g + 2], o[4 * g + 3]); *(u32x2*)(OD + orow + vb * 32 + 8 * g) = w; } }
        }
#pragma unroll
        for (int kb = 0; kb < 2; ++kb) { const unsigned char* ke = wl + HW_KET + (32 * kb + x) * 80 + hh * 16; const bf16x8 ke0 = *(const bf16x8*)ke, ke1 = *(const bf16x8*)(ke + 32);
            f32x4 d4[4];
#pragma unroll
            for (int g = 0; g < 4; ++g) d4[g] = *(const f32x4*)(wl + HW_DEC + (32 * kb + 8 * g + 4 * hh) * 4);
#pragma unroll
            for (int vb = 0; vb < 2; ++vb) { const unsigned char* vt = vb ? vt1 : vt0;
#pragma unroll
                for (int r = 0; r < 16; ++r) S[kb][vb][r] *= d4[r >> 2][r & 3];
                S[kb][vb] = MFMA32(ke0, *(const bf16x8*)(vt), S[kb][vb]); S[kb][vb] = MFMA32(ke1, *(const bf16x8*)(vt + 32), S[kb][vb]); } }
        WAVE_LDS_SYNC();
#undef TOKOFF
    }
    if (so) {
#pragma unroll
        for (int kb = 0; kb < 2; ++kb)
#pragma unroll
            for (int vb = 0; vb < 2; ++vb)
#pragma unroll
                for (int r = 0; r < 16; ++r) so[(32 * kb + (r & 3) + 8 * (r >> 2) + 4 * hh) * 64 + 32 * vb + x] = S[kb][vb][r];
    }
    if (ddo) ddo[lane] = Dtot;
}
__device__ __forceinline__ void hgrn_passA(unsigned char* sm, unsigned char* ws, int c, int G) {
    int tid_ = threadIdx.x; asm volatile("" : "+v"(tid_));
    const int lane = tid_ & 63, w = __builtin_amdgcn_readfirstlane(tid_ >> 6), x = lane & 31, hh = lane >> 5;
    for (int id = c + G * w; id < 1024 && w < 4; id += 4 * G) {
        const int sc = id & 15, dir = (id >> 4) & 1, h = (id >> 5) & 7, b = id >> 8;
        const bf16_t* KK = (const bf16_t*)(ws + (dir ? WS_KKB : WS_KKF));
        float* SL = (float*)(ws + WS_SL) + (size_t)id * 4096; float* DD = (float*)(ws + WS_DD) + (size_t)id * 64;
        const size_t row0 = (size_t)TP + (size_t)b * 4096 + sc * 256; const bf16_t* HI = (const bf16_t*)(ws + WS_HI);
        if (dir) hg_chain<false, 1>(sm + w * HW_BYTES, KK, KK, HI, nullptr, row0, h, lane, nullptr, nullptr, nullptr, 0, 0, SL, DD);
        else hg_chain<false, 0>(sm + w * HW_BYTES, KK, KK, HI, nullptr, row0, h, lane, nullptr, nullptr, nullptr, 0, 0, SL, DD);
    }
}
__device__ __forceinline__ void hgrn_passC(unsigned char* sm, unsigned char* ws, const float* state_in, const float* g_hg, float* out, int c, int G) {
    int tid_ = threadIdx.x; asm volatile("" : "+v"(tid_));
    const int tid = tid_, lane = tid & 63, w = __builtin_amdgcn_readfirstlane(tid >> 6), x = lane & 31, hh = lane >> 5;
    {
        const int slot = w >> 1, dir = w & 1, item = c + G * slot;
        if (slot < 3 && item < 768) {
            const bool prompt = item < 256; const int u = item - 256;
            const int b = prompt ? item >> 3 : u >> 7, h = prompt ? item & 7 : (u >> 4) & 7, sc = prompt ? 0 : u & 15;
            const size_t row0 = prompt ? (size_t)b * 256 : (size_t)TP + (size_t)b * 4096 + sc * 256;
            const float* s0 = prompt ? nullptr : state_in + ((size_t)(b * 2 + dir) * 8 + h) * 4096;
            const int ibase = ((b * 8 + h) * 2 + dir) * 16; const int nf = prompt ? 0 : (dir ? 15 - sc : sc); const int it0 = ibase + (dir ? 15 : 0);
            const float* SLf = (const float*)(ws + WS_SL) + (size_t)it0 * 4096; const float* DDf = (const float*)(ws + WS_DD) + (size_t)it0 * 64;
            float* so = prompt ? out + OUT_STATE + ((size_t)(b * 2 + dir) * 8 + h) * 4096 : nullptr;
            bf16_t* KKm = (bf16_t*)(ws + (dir ? WS_KKB : WS_KKF)); const bf16_t* HQ = (const bf16_t*)(ws + WS_HQ); const bf16_t* HI = (const bf16_t*)(ws + WS_HI);
            if (dir) hg_chain<true, 1>(sm + w * HW_BYTES, KKm, HQ, HI, KKm, row0, h, lane, s0, SLf, DDf, nf, -1, so, nullptr);
            else hg_chain<true, 0>(sm + w * HW_BYTES, KKm, HQ, HI, KKm, row0, h, lane, s0, SLf, DDf, nf, 1, so, nullptr);
        }
    }
    asm volatile("s_waitcnt vmcnt(0)" ::: "memory");
    __syncthreads();
    const int tq = tid >> 4, vq = tid & 15;
    for (int slot = 0; slot < 3; ++slot) { const int item = c + G * slot; if (item >= 768) break;
        const bool prompt = item < 256; const int u = item - 256;
        const int b = prompt ? item >> 3 : u >> 7, h = prompt ? item & 7 : (u >> 4) & 7, sc = prompt ? 0 : u & 15;
        const size_t row0 = prompt ? (size_t)b * 256 : (size_t)TP + (size_t)b * 4096 + sc * 256;
        const f32x4 g4 = *(const f32x4*)(g_hg + h * 64 + vq * 4);
        for (int ps = 0; ps < 8; ++ps) { const size_t off = (row0 + ps * 32 + tq) * 512 + (size_t)h * 64 + vq * 4;
            const unsigned long long wf = __hip_atomic_load((const unsigned long long*)((const bf16_t*)(ws + WS_KKF) + off), __ATOMIC_RELAXED, __HIP_MEMORY_SCOPE_AGENT);
            const unsigned long long wb = __hip_atomic_load((const unsigned long long*)((const bf16_t*)(ws + WS_KKB) + off), __ATOMIC_RELAXED, __HIP_MEMORY_SCOPE_AGENT);
            bf16_t* hp = (bf16_t*)(ws + WS_HG) + off; const u32x2 hg = *(const u32x2*)hp;
            const unsigned f0 = (unsigned)wf, f1 = (unsigned)(wf >> 32), b0 = (unsigned)wb, b1 = (unsigned)(wb >> 32);
            const float t0 = bflo(f0) + bflo(b0), t1 = bfhi(f0) + bfhi(b0), t2 = bflo(f1) + bflo(b1), t3 = bfhi(f1) + bfhi(b1);
            float ss = t0 * t0 + t1 * t1 + t2 * t2 + t3 * t3;
            ss += __shfl_xor(ss, 1); ss += __shfl_xor(ss, 2); ss += __shfl_xor(ss, 4); ss += __shfl_xor(ss, 8);
            const float rr = __builtin_amdgcn_rsqf(ss * (1.f / 64.f) + EPS);
            u32x2 o; o.x = cvtpk(t0 * rr * g4[0] * bflo(hg.x), t1 * rr * g4[1] * bfhi(hg.x)); o.y = cvtpk(t2 * rr * g4[2] * bflo(hg.y), t3 * rr * g4[3] * bfhi(hg.y));
            *(u32x2*)hp = o; }
    }
}

__device__ __forceinline__ void conv_item(const float* W, int ldw, int srccol, const float* kscale, bf16_t* WT, int K, int n0, int k0, float* scr, int lane) {
    const float* wp = W + (size_t)k0 * ldw + (srccol >= 0 ? srccol : 0);
#pragma unroll 16
    for (int kk = 0; kk < 64; ++kk) { float v = wp[(size_t)kk * ldw]; if (kscale) v *= kscale[k0 + kk]; scr[kk * 65 + lane] = (srccol >= 0) ? v : 0.f; }
    __builtin_amdgcn_s_waitcnt(0xc07f); asm volatile("" ::: "memory");
    const int c = lane & 7;
#pragma unroll
    for (int j = 0; j < 8; ++j) { const int n = (lane >> 3) + 8 * j; const float* q = scr + (8 * c) * 65 + n;
        u32x4 o; o.x = cvtpk(q[0 * 65], q[1 * 65]); o.y = cvtpk(q[2 * 65], q[3 * 65]); o.z = cvtpk(q[4 * 65], q[5 * 65]); o.w = cvtpk(q[6 * 65], q[7 * 65]);
        *(u32x4*)(WT + (size_t)(n0 + n) * K + k0 + 8 * c) = o; }
    __builtin_amdgcn_s_waitcnt(0xc07f); asm volatile("" ::: "memory");
}
constexpr int CV_I0 = 52 * 16, CV_I1 = 32 * 16, CV_I2 = 12 * 6, CV_I3 = 8 * 4, CV_I4 = 8 * 4, CV_I5 = 16 * 8, CV_I6 = 16 * 8, CV_I7 = 16 * 16, CV_I8 = 64 * 16, CV_I9 = 16 * 64;
constexpr int CV_EARLY2 = CV_I2 + CV_I3 + CV_I4, CV_NE = CV_I0 + CV_EARLY2, CV_NL = CV_I1 + CV_I5 + CV_I6 + CV_I7 + CV_I8 + CV_I9;
static_assert(CV_NL == 3072, "late conversion items: 12 per workgroup");
typedef const __attribute__((address_space(4))) char* kargp_t;
__device__ __forceinline__ const float* inp(int i) {
    kargp_t kp = (kargp_t)__builtin_amdgcn_kernarg_segment_ptr();
    asm volatile("" : "+s"(kp));
    return (const float*)(*(const unsigned long long __attribute__((address_space(4)))*)(kp + i * 8));
}
__device__ __forceinline__ void conv_dispatch(int r, unsigned char* ws, float* scr, int lane) {
    if (r < CV_I0) { const int kb = r / 52, nb = r % 52, n = nb * 64 + lane; const int src = n < 256 ? 384 + n : n < 640 ? n - 256 : n < 672 ? n : n < 768 ? -1 : n - 96;
        conv_item(inp(11), NIN, src, nullptr, (bf16_t*)(ws + WS_WIN), 1024, nb * 64, kb * 64, scr, lane); return; } r -= CV_I0;
    if (r < CV_I1) { const int kb = r >> 5, nb = r & 31; conv_item(inp(11), NIN, 3232 + nb * 64 + lane, nullptr, (bf16_t*)(ws + WS_WG), 1024, nb * 64, kb * 64, scr, lane); return; } r -= CV_I1;
    if (r < CV_I2) { const int kb = r / 12, nb = r % 12; conv_item(inp(13), 768, nb * 64 + lane, inp(12), (bf16_t*)(ws + WS_WUQ), 384, nb * 64, kb * 64, scr, lane); return; } r -= CV_I2;
    if (r < CV_I3) { const int kb = r >> 3, nb = r & 7; conv_item(inp(15), 1024, nb * 128 + lane, inp(14), (bf16_t*)(ws + WS_WUK), 256, nb * 64, kb * 64, scr, lane); return; } r -= CV_I3;
    if (r < CV_I4) { const int kb = r >> 3, nb = r & 7; conv_item(inp(15), 1024, nb * 128 + 64 + lane, inp(14), (bf16_t*)(ws + WS_WUV), 256, nb * 64, kb * 64, scr, lane); return; } r -= CV_I4;
    if (r < CV_I5) { const int kb = r >> 4, nb = r & 15; conv_item(inp(18), 1024, nb * 64 + lane, nullptr, (bf16_t*)(ws + WS_W1), 512, nb * 64, kb * 64, scr, lane); return; } r -= CV_I5;
    if (r < CV_I6) { const int kb = r >> 4, nb = r & 15; conv_item(inp(19), 1024, nb * 64 + lane, nullptr, (bf16_t*)(ws + WS_W2), 512, nb * 64, kb * 64, scr, lane); return; } r -= CV_I6;
    if (r < CV_I7) { const int kb = r >> 4, nb = r & 15; conv_item(inp(20), 1024, nb * 64 + lane, nullptr, (bf16_t*)(ws + WS_WOUT), 1024, nb * 64, kb * 64, scr, lane); return; } r -= CV_I7;
    if (r < CV_I8) { const int kb = r >> 6, nb = r & 63; conv_item(inp(21), 4096, nb * 64 + lane, nullptr, (bf16_t*)(ws + WS_WFF1), 1024, nb * 64, kb * 64, scr, lane); return; } r -= CV_I8;
    { const int kb = r >> 4, nb = r & 15; conv_item(inp(22), 1024, nb * 64 + lane, nullptr, (bf16_t*)(ws + WS_WFF2), 4096, nb * 64, kb * 64, scr, lane); }
}
__device__ __forceinline__ void sincos_small(float xx, float& s, float& c) {
    const float n = rintf(xx * 0.636619772367581f);
    float r = fmaf(n, -1.5703125f, xx); r = fmaf(n, -4.837512969970703125e-4f, r); r = fmaf(n, -7.54978995489188e-8f, r);
    const float z = r * r;
    const float sp = r + r * z * (-1.6666654611e-1f + z * (8.3321608736e-3f + z * (-1.9515295891e-4f)));
    const float cp = 1.f - 0.5f * z + z * z * (4.166664568298827e-2f + z * (-1.388731625493765e-3f + z * 2.443315711809948e-5f));
    const int q = ((int)n) & 3;
    s = (q == 0) ? sp : (q == 1) ? cp : (q == 2) ? -sp : -cp;
    c = (q == 0) ? cp : (q == 1) ? -sp : (q == 2) ? -cp : sp;
}
__device__ __forceinline__ void modnorm_row(const float* xrow, const float* g, const float* sc, const float* sh, bf16_t* orow, int lane) {
    const f32x4* xr = (const f32x4*)xrow + lane; f32x4 v[4]; float s = 0.f;
#pragma unroll
    for (int j = 0; j < 4; ++j) { v[j] = xr[64 * j]; s += v[j][0] * v[j][0] + v[j][1] * v[j][1] + v[j][2] * v[j][2] + v[j][3] * v[j][3]; }
    const float r = __builtin_amdgcn_rsqf(wave_sum(s) * (1.f / 1024.f) + EPS);
#pragma unroll
    for (int j = 0; j < 4; ++j) { const int c = (lane + 64 * j) * 4; const f32x4 gg = *(const f32x4*)(g + c), s1 = *(const f32x4*)(sc + c), s2 = *(const f32x4*)(sh + c);
        const f32x4 y = v[j] * r * gg * (1.f + s1) + s2; u32x2 w; w.x = cvtpk(y[0], y[1]); w.y = cvtpk(y[2], y[3]); *(u32x2*)(orow + c) = w; }
}

#define PH_IDS int tid = threadIdx.x; asm volatile("" : "+v"(tid)); const int lane = tid & 63, wave = tid >> 6, gw = c * 8 + wave, NGW = G * 8, gt = c * 512 + tid, NGT = G * 512; (void)lane; (void)wave; (void)gw; (void)NGW; (void)gt; (void)NGT;
#ifndef PROBE_PH
#define PROBE_PH -1
#endif
#define PB(k) unsigned long long pb_t0_ = 0; if (PROBE_PH == (k) && blockIdx.x == 0 && threadIdx.x == 0) pb_t0_ = __builtin_amdgcn_s_memrealtime();
#define PE(k) if (PROBE_PH == (k) && blockIdx.x == 0 && threadIdx.x == 0) { const unsigned long long t1_ = __builtin_amdgcn_s_memrealtime(); const unsigned long long dt_ = t1_ - pb_t0_; while (__builtin_amdgcn_s_memrealtime() - t1_ < dt_) __builtin_amdgcn_s_sleep(8); }
__global__ void __launch_bounds__(512, 2) fwd_mega(Ptrs P) {
    extern __shared__ __attribute__((aligned(16))) unsigned char lds[];
    cg::grid_group grid = cg::this_grid();
    const int c = blockIdx.x, G = gridDim.x;
    unsigned char* ws = P.ws; float* out = P.out;
    volatile LAS unsigned* bst = (volatile LAS unsigned*)((LAS unsigned char*)lds + LDS_BYTES - 64);
    if (threadIdx.x < 2) bst[threadIdx.x] = 0u;
    if (c == 0) for (int i = threadIdx.x; i < XCD_BAR_WORDS; i += 512) ((unsigned*)(ws + WS_BAR))[i] = 0u;
    LAS unsigned char* lds3 = (LAS unsigned char*)lds;
    float* mods = (float*)(ws + WS_MODS);

#ifndef SKIP_PH0
    { PB(0)
    {
        PH_IDS
        float* rs = (float*)(ws + WS_RSQ); for (int i = gt; i < 65536; i += NGT) rs[i] = 0.f;
        { float* rs2 = (float*)(ws + WS_RS2); for (int i = gt; i < T; i += NGT) rs2[i] = 0.f; }
        float* rope = (float*)(ws + WS_ROPE);
        for (int i = gt; i < 4096 * 16; i += NGT) { const int pos = i >> 4, pr = i & 15; const float p = (pr < 8) ? (float)(pos >> 6) : (float)(pos & 63);
            const float ang = p * exp2f(-1.6609640474436813f * (float)(pr & 7)); float s, cc; sincos_small(ang, s, cc); rope[2 * i] = cc; rope[2 * i + 1] = s; }
        { const float* lg = inp(17); float* lb = (float*)(ws + WS_LB); for (int i = gt; i < 1024; i += NGT) lb[i] = 1.f / (1.f + __expf(lg[i] - lg[1024 + i])); }
        { const float* cc = inp(2); const float* gk = inp(14); bf16_t* CK = (bf16_t*)(ws + WS_CKVA);
          for (int i = gt; i < 2048 * 256 / 2; i += NGT) { const int e = i * 2, r = e >> 8, col = e & 255, b = r >> 9, j = r & 511;
              const size_t kr = (size_t)TP + (size_t)b * NKS + 4096 + j; *(unsigned*)(CK + kr * 256 + col) = cvtpk(cc[e] / gk[col], cc[e + 1] / gk[col + 1]); }
          const float* ck = inp(3); bf16_t* KRb = (bf16_t*)((unsigned char*)out + DO_KR);
          for (int i = gt; i < 2048 * 32 / 2; i += NGT) { const int e = i * 2, r = e >> 5, col = e & 31, b = r >> 9, j = r & 511;
              const size_t kr = (size_t)TP + (size_t)b * NKS + 4096 + j; *(unsigned*)(KRb + kr * 32 + col) = cvtpk(ck[e], ck[e + 1]); } }
        if (c < 96) {
            const float* wa = inp(7); const float* ba = inp(8); const float* cv = inp(5); const float* cx = inp(6);
            float* sl = (float*)lds;
            for (int i = tid; i < 5120; i += 512) sl[i] = silu(i < 4096 ? cv[i] : cx[i - 4096]);
            __syncthreads();
            float a0 = 0.f, a1 = 0.f, a2 = 0.f, a3 = 0.f, a4 = 0.f; const int col = c * 64 + lane;
#pragma unroll 32
            for (int k = wave * 128; k < wave * 128 + 128; ++k) { const float wv = wa[(size_t)k * 6144 + col];
                a0 = fmaf(sl[k], wv, a0); a1 = fmaf(sl[1024 + k], wv, a1); a2 = fmaf(sl[2048 + k], wv, a2); a3 = fmaf(sl[3072 + k], wv, a3); a4 = fmaf(sl[4096 + k], wv, a4); }
            float* red = (float*)lds + 5120 + wave * 320;
            red[lane] = a0; red[64 + lane] = a1; red[128 + lane] = a2; red[192 + lane] = a3; red[256 + lane] = a4;
            __syncthreads();
            if (tid < 320) { float sacc = 0.f; for (int w2 = 0; w2 < 8; ++w2) sacc += ((float*)lds + 5120)[w2 * 320 + tid]; const int cd = tid >> 6, l2 = tid & 63; mods[cd * 6144 + c * 64 + l2] = sacc + ba[c * 64 + l2]; }
            __syncthreads();
        }
        float* scr = (float*)(lds + wave * 16640);
        for (int e = gw; e < CV_NE; e += NGW) conv_dispatch(e < CV_I0 ? e : e + CV_I1, ws, scr, lane);
    }
    PE(0) }
#endif
    grid.sync();
    const XcdBarrier xbar = xcd_barrier_post((unsigned*)(ws + WS_BAR), bst);

#ifndef SKIP_PH0B
    { PB(1)
    { PH_IDS
    {
        const float* w1 = inp(21); const int n0 = c * 16, col = tid & 15, ks = tid >> 4;
        float a0 = 0.f, a1 = 0.f, a2 = 0.f, a3 = 0.f, a4 = 0.f;
#pragma unroll 8
        for (int k = ks * 32; k < ks * 32 + 32; ++k) { const float wv = w1[(size_t)k * 4096 + n0 + col];
            a0 = fmaf(mods[3 * 1024 + k], wv, a0); a1 = fmaf(mods[6144 + 3 * 1024 + k], wv, a1); a2 = fmaf(mods[2 * 6144 + 3 * 1024 + k], wv, a2); a3 = fmaf(mods[3 * 6144 + 3 * 1024 + k], wv, a3); a4 = fmaf(mods[4 * 6144 + 3 * 1024 + k], wv, a4); }
        float* red = (float*)lds;
        red[(0 * 32 + ks) * 16 + col] = a0; red[(1 * 32 + ks) * 16 + col] = a1; red[(2 * 32 + ks) * 16 + col] = a2; red[(3 * 32 + ks) * 16 + col] = a3; red[(4 * 32 + ks) * 16 + col] = a4;
        __syncthreads();
        if (tid < 80) { const int cd = tid >> 4, cl = tid & 15; float sacc = 0.f; for (int q = 0; q < 32; ++q) sacc += red[(cd * 32 + q) * 16 + cl]; ((float*)(ws + WS_BV))[cd * 4096 + n0 + cl] = sacc; }
        __syncthreads();
    }
    for (int r = gw; r < T; r += NGW) { const float* md = mods + (size_t)cond_of(r) * 6144;
        modnorm_row(r < TP ? inp(0) + (size_t)r * 1024 : inp(1) + (size_t)(r - TP) * 1024, inp(9), md + 1024, md, (bf16_t*)(ws + WS_H) + (size_t)r * 1024, lane); } }
    PE(1) }
#endif
    xcd_barrier(xbar);
#ifndef SKIP_PH1
    { PB(2)
    { RangeSched S{(const char*)(ws + WS_H), (const char*)(ws + WS_WIN), (size_t)256 * 1024 * 2, (size_t)256 * 1024 * 2, 13, 96 * 13, c, G, 0};
      EpiIn E{ws, out}; pg8::gemm_phase(lds3, 1024, 1024, 1024, S, E); }
    PE(2) }
#endif
    xcd_barrier(xbar);
#ifndef SKIP_PH2
    { PB(3)
    { RangeSched SQ{(const char*)(ws + WS_QLAT), (const char*)(ws + WS_WUQ), (size_t)256 * 384 * 2, (size_t)256 * 384 * 2, 3, 288, first_of(0, c, G), G, 0};
      EpiQ EQ{ws, out}; pg8::gemm_phase(lds3, 384, 384, 384, SQ, EQ);
      RangeSched SK{(const char*)(ws + WS_CKVA), (const char*)(ws + WS_WUK), (size_t)256 * 256 * 2, (size_t)256 * 256 * 2, 2, 208, first_of(288, c, G), G, 0};
      EpiK EK{ws, out}; pg8::gemm_phase(lds3, 256, 256, 256, SK, EK);
      RangeSched SV{(const char*)(ws + WS_CKVA), (const char*)(ws + WS_WUV), (size_t)256 * 256 * 2, (size_t)256 * 256 * 2, 2, 208, first_of(496, c, G), G, 0};
      EpiV EV{ws, out}; pg8::gemm_phase(lds3, 256, 256, 256, SV, EV);
      { PH_IDS
 const bf16_t* CK = (const bf16_t*)(ws + WS_CKVA); const float* rskv = (const float*)(ws + WS_RSKV); const float* gk = inp(14);
        for (int i = gt; i < TP * 256 / 4; i += NGT) { const int e = i * 4, r = e >> 8, col = e & 255; const float rr = __builtin_amdgcn_rsqf(rskv[r] * (1.f / 256.f) + EPS);
            const u32x2 w = *(const u32x2*)(CK + e); const f32x4 g4 = *(const f32x4*)(gk + col);
            *(f32x4*)(out + OUT_CKV + e) = (f32x4){bflo(w.x) * rr * g4[0], bfhi(w.x) * rr * g4[1], bflo(w.y) * rr * g4[2], bfhi(w.y) * rr * g4[3]}; } }
      __syncthreads();
      hgrn_passA(lds, ws, c, G);
      { int tid2 = threadIdx.x; asm volatile("" : "+v"(tid2)); const int w = __builtin_amdgcn_readfirstlane(tid2 >> 6), ln = tid2 & 63;
        float* scr2 = (float*)(lds + (w < 4 ? w * HW_BYTES : 79872 + (w - 4) * 16640));
        const int nmine = w < 4 ? 1 : 2, l0 = w < 4 ? 8 + w : w - 4;
        for (int j = 0; j < nmine; ++j) { const int l = c * 12 + l0 + 4 * j; conv_dispatch(l < CV_I1 ? CV_I0 + l : l - CV_I1 + CV_I0 + CV_I1 + CV_EARLY2, ws, scr2, ln); } }
    }
    PE(3) }
#endif
    xcd_barrier(xbar);
#ifndef SKIP_PH3
    { PB(4)
    {
        const bf16_t* Q = (const bf16_t*)((unsigned char*)out + DO_Q); const bf16_t* Kn = (const bf16_t*)((unsigned char*)out + DO_KN); const bf16_t* KRb = (const bf16_t*)((unsigned char*)out + DO_KR);
        bf16_t* OM = (bf16_t*)(ws + WS_OMLA);
        for (int u = c; u < 512; u += G) { const int b = u >> 7, h = (u >> 4) & 7, qb = u & 15; const size_t qrow = (size_t)TP + (size_t)b * 4096 + qb * 256, kr0 = (size_t)TP + (size_t)b * NKS;
            attn_unit(lds, Q + qrow * 768, Kn + kr0 * 512, KRb + kr0 * 32, (const bf16_t*)((unsigned char*)out + DO_VTS) + ((size_t)(b * 8 + h) * 64) * NKS, NKS, h, OM + qrow * 512); }
        for (int u = c; u < 256; u += G) { const int b = u >> 3, h = u & 7; const size_t qrow = (size_t)b * 256;
            attn_unit(lds, Q + qrow * 768, Kn + qrow * 512, KRb + qrow * 32, (const bf16_t*)((unsigned char*)out + DO_VTP) + ((size_t)(b * 8 + h) * 64) * 256, 256, h, OM + qrow * 512); }
        hgrn_passC(lds, ws, inp(4), inp(16), out, c, G);
    }
    PE(4) }
#endif
    xcd_barrier(xbar);
#ifndef SKIP_PH4A
    { PB(5)
    { RangeSched S{(const char*)(ws + WS_H), (const char*)(ws + WS_WG), (size_t)256 * 1024 * 2, (size_t)256 * 1024 * 2, 8, 768, c, G, 0};
      EpiGate E{ws}; pg8::gemm_phase(lds3, 1024, 1024, 1024, S, E); }
    PE(5) }
#endif
    xcd_barrier(xbar);
#ifndef SKIP_PH4B
    { PB(6)
    { MergeSched S{(const char*)(ws + WS_OMLA), (const char*)(ws + WS_HG), (const char*)(ws + WS_W1), (const char*)(ws + WS_W2), (size_t)256 * 512 * 2, (size_t)256 * 512 * 2, 384, c, G};
      EpiMerge E{ws}; pg8::gemm_phase(lds3, 512, 512, 512, S, E); }
    PE(6) }
#endif
    xcd_barrier(xbar);
#ifndef SKIP_PH5
    { PB(7)
    { RangeSched S{(const char*)(ws + WS_MERGED), (const char*)(ws + WS_WOUT), (size_t)256 * 1024 * 2, (size_t)256 * 1024 * 2, 4, 384, c, G, 0};
      EpiRes E{inp(0), inp(1), out, mods + 2 * 1024, (bf16_t*)(ws + WS_H2), inp(10), (float*)(ws + WS_RS2)}; pg8::gemm_phase(lds3, 1024, 1024, 1024, S, E); }
    PE(7) }
#endif
    xcd_barrier(xbar);
#ifndef SKIP_PH67
    { PB(9)
#pragma unroll
    for (int hf = 0; hf < 2; ++hf) {
        { RangeSched S{(const char*)(ws + WS_H2) + (size_t)hf * 12288 * 1024 * 2, (const char*)(ws + WS_WFF1), (size_t)256 * 1024 * 2, (size_t)256 * 1024 * 2, 16, 768, c, G, hf * 48};
          EpiFF1 E{ws, hf * 12288}; pg8::gemm_phase(lds3, 1024, 1024, 1024, S, E); }
        xcd_barrier(xbar);
        { RangeSched S{(const char*)(ws + WS_HID), (const char*)(ws + WS_WFF2), (size_t)256 * 4096 * 2, (size_t)256 * 4096 * 2, 4, 192, c, G, hf * 48};
          EpiRes E{nullptr, nullptr, out, mods + 5 * 1024, nullptr, nullptr, nullptr}; pg8::gemm_phase(lds3, 4096, 4096, 4096, S, E); }
        xcd_barrier(xbar);
    }
    PE(9) }
#endif
#ifndef SKIP_PH8
    { PB(10)
    { PH_IDS
      const float* gf = inp(23);
      for (int r = gw; r < T; r += NGW) { f32x4* xr = (f32x4*)(out + (size_t)r * 1024) + lane; f32x4 v[4]; float s = 0.f;
#pragma unroll
          for (int j = 0; j < 4; ++j) { v[j] = xr[64 * j]; s += v[j][0] * v[j][0] + v[j][1] * v[j][1] + v[j][2] * v[j][2] + v[j][3] * v[j][3]; }
          const float rr = __builtin_amdgcn_rsqf(wave_sum(s) * (1.f / 1024.f) + EPS);
#pragma unroll
          for (int j = 0; j < 4; ++j) xr[64 * j] = v[j] * rr * *(const f32x4*)(gf + (lane + 64 * j) * 4); } }
    PE(10) }
#endif
}

extern "C" void kernel_launch(void* const* d_in, const int* in_sizes, int n_in, void* d_out, int out_size, void* d_ws, size_t ws_size, hipStream_t stream) {
    static int grid = 0;
    if (grid == 0) {
        int dev = 0, cus = 0, per_cu = 0;
        hipGetDevice(&dev); hipDeviceGetAttribute(&cus, hipDeviceAttributeMultiprocessorCount, dev);
        hipFuncSetAttribute((const void*)fwd_mega, hipFuncAttributeMaxDynamicSharedMemorySize, LDS_BYTES);
        hipOccupancyMaxActiveBlocksPerMultiprocessor(&per_cu, (const void*)fwd_mega, 512, LDS_BYTES);
        if (per_cu < 1) { fprintf(stderr, "kernel_launch: occupancy query says %d blocks per CU\n", per_cu); per_cu = 1; }
        grid = cus;
        if (grid > 256) grid = 256;
        (void)hipGetLastError();
    }
    Ptrs p{};
    for (int i = 0; i < 24; ++i) p.in[i] = (const float*)d_in[i];
    p.out = (float*)d_out; p.ws = (unsigned char*)d_ws;
    void* args[] = {&p};
    hipError_t e = hipLaunchCooperativeKernel((const void*)fwd_mega, dim3(grid), dim3(512), args, LDS_BYTES, stream);
    if (e != hipSuccess) fprintf(stderr, "cooperative launch failed: %s (grid %d)\n", hipGetErrorString(e), grid);
}
```
